# Optimizing an MI355X kernel written in HIP

```python
import math
import jax, jax.numpy as jnp
from jax import lax
import numpy as np

D_MODEL = 2048
BATCH = 8
SEQ = 2048
DEPTH = 1

MEM_LEN = 256
MEM_HEADS = 4
MEM_HEAD_DIM = 128
CHUNK = 128
GMLP_HEADS = 8
GMLP_HEAD_DIM = 128
GMLP_WIDTH = GMLP_HEADS * GMLP_HEAD_DIM
MLA_HEADS = 8
Q_LORA = 512
KV_LORA = 256
QK_NOPE = 128
QK_ROPE = 64
V_DIM = 128
MLA_WIDTH = MLA_HEADS * V_DIM
Q_BLOCK = 128
ROPE_THETA = 10000.0
IN_WIDTH = 2 * GMLP_WIDTH + Q_LORA + KV_LORA + QK_ROPE
MIX_WIDTH = GMLP_WIDTH + MLA_WIDTH
N_GROUPS = 8
EXPERTS_PER_GROUP = 8
N_EXPERTS = N_GROUPS * EXPERTS_PER_GROUP
TOP_K = 2
D_EXPERT = 512
MOE_BLOCK = 128
EPS = 1e-6

kernel_name = "hybrid_gmlp_mla_memxattn_hiermoe"


def rms_norm(x, g):
    xf = x.astype(jnp.float32)
    y = xf * lax.rsqrt(jnp.mean(xf * xf, axis=-1, keepdims=True) + EPS)
    return (y * g.astype(jnp.float32)).astype(x.dtype)


def layer_norm(x, g, b):
    xf = x.astype(jnp.float32)
    mu = jnp.mean(xf, axis=-1, keepdims=True)
    var = jnp.mean(jnp.square(xf - mu), axis=-1, keepdims=True)
    y = (xf - mu) * lax.rsqrt(var + 1e-5)
    return (y * g.astype(jnp.float32) + b.astype(jnp.float32)).astype(x.dtype)


def rotary(t, cos, sin):
    half = t.shape[-1] // 2
    t1, t2 = t[..., :half], t[..., half:]
    return jnp.concatenate([t1 * cos - t2 * sin, t2 * cos + t1 * sin], axis=-1)


def gmlp_group(z_uv, g_v, b_v, w_spatial, b_spatial):
    B, S, _ = z_uv.shape
    uv = jax.nn.gelu(z_uv)
    u, v = uv[..., :GMLP_WIDTH], uv[..., GMLP_WIDTH:]
    v = layer_norm(v, g_v, b_v)
    v = v.reshape(B, S // CHUNK, CHUNK, GMLP_HEADS, GMLP_HEAD_DIM)
    causal = jnp.tril(jnp.ones((CHUNK, CHUNK), dtype=bool))
    ws = jnp.where(causal[None], w_spatial, 0.0).astype(v.dtype)
    sv = jnp.einsum('gts,bnsgc->bntgc', ws, v)
    sv = sv + b_spatial.T.astype(v.dtype)[None, None, :, :, None]
    return u * sv.reshape(B, S, GMLP_WIDTH)


def mla_group(c_q, c_kv, k_rope, g_q_lora, w_uq, g_kv_lora, w_ukv):
    B, S, _ = c_q.shape
    q = (rms_norm(c_q, g_q_lora) @ w_uq).reshape(B, S, MLA_HEADS, QK_NOPE + QK_ROPE)
    q_nope, q_rope = q[..., :QK_NOPE], q[..., QK_NOPE:]
    kv = (rms_norm(c_kv, g_kv_lora) @ w_ukv).reshape(B, S, MLA_HEADS, QK_NOPE + V_DIM)
    k_nope, v = kv[..., :QK_NOPE], kv[..., QK_NOPE:]

    pos = jnp.arange(S, dtype=jnp.float32)
    inv_freq = ROPE_THETA ** (-jnp.arange(0, QK_ROPE, 2, dtype=jnp.float32) / QK_ROPE)
    ang = pos[:, None] * inv_freq[None, :]
    cos, sin = jnp.cos(ang).astype(q.dtype), jnp.sin(ang).astype(q.dtype)
    q_rope = rotary(q_rope, cos[None, :, None, :], sin[None, :, None, :])
    k_rope = rotary(k_rope, cos[None], sin[None])

    nb = S // Q_BLOCK
    scale = 1.0 / math.sqrt(QK_NOPE + QK_ROPE)
    k_idx = jnp.arange(S)

    def to_blocks(t):
        return jnp.moveaxis(t.reshape(B, nb, Q_BLOCK, *t.shape[2:]), 1, 0)

    def attend(args):
        qn, qr, blk = args
        s = (jnp.einsum('bqhd,bkhd->bhqk', qn, k_nope)
             + jnp.einsum('bqhr,bkr->bhqk', qr, k_rope)).astype(jnp.float32) * scale
        q_idx = blk * Q_BLOCK + jnp.arange(Q_BLOCK)
        s = jnp.where(k_idx[None, :] <= q_idx[:, None], s, jnp.finfo(jnp.float32).min)
        p = jax.nn.softmax(s, axis=-1).astype(v.dtype)
        return jnp.einsum('bhqk,bkhd->bqhd', p, v)

    o = lax.map(attend, (to_blocks(q_nope), to_blocks(q_rope), jnp.arange(nb)))
    return jnp.moveaxis(o, 0, 1).reshape(B, S, MLA_WIDTH)


def memory_cross_attention(h, mem_n, w_mq, w_mk, w_mv, w_mo):
    B, S, _ = h.shape
    q = (h @ w_mq).reshape(B, S, MEM_HEADS, MEM_HEAD_DIM)
    k = (mem_n @ w_mk).reshape(B, -1, MEM_HEADS, MEM_HEAD_DIM)
    v = (mem_n @ w_mv).reshape(B, -1, MEM_HEADS, MEM_HEAD_DIM)
    s = jnp.einsum('bshd,bmhd->bhsm', q, k).astype(jnp.float32) / math.sqrt(MEM_HEAD_DIM)
    p = jax.nn.softmax(s, axis=-1).astype(v.dtype)
    o = jnp.einsum('bhsm,bmhd->bshd', p, v).reshape(B, S, MEM_HEADS * MEM_HEAD_DIM)
    return o @ w_mo


def hierarchical_moe(h, w_rg, b_rg, w_re, b_re, w_gate, w_up, w_down):
    B, S, D = h.shape
    T = B * S
    ht = h.reshape(T, D)
    g_logits = (ht @ w_rg + b_rg).astype(jnp.float32)
    g_prob = jax.nn.softmax(g_logits, axis=-1)
    grp = jnp.argmax(g_logits, axis=-1)
    p_grp = jnp.take_along_axis(g_prob, grp[:, None], axis=-1)
    e_logits = (ht @ w_re + b_re).astype(jnp.float32).reshape(T, N_GROUPS, EXPERTS_PER_GROUP)
    e_logits = jnp.take_along_axis(e_logits, grp[:, None, None], axis=1)[:, 0]
    e_prob = jax.nn.softmax(e_logits, axis=-1)
    top_p, top_i = lax.top_k(e_prob, TOP_K)
    top_p = top_p / jnp.sum(top_p, axis=-1, keepdims=True)
    gates = (p_grp * top_p).astype(h.dtype)
    expert_idx = grp[:, None] * EXPERTS_PER_GROUP + top_i

    A = T * TOP_K
    P = A + N_EXPERTS * MOE_BLOCK
    NB = P // MOE_BLOCK
    flat_e = expert_idx.reshape(A).astype(jnp.int32)
    flat_tok = jnp.repeat(jnp.arange(T, dtype=jnp.int32), TOP_K)
    flat_w = gates.reshape(A)
    order = jnp.argsort(flat_e)
    sorted_e = flat_e[order]
    counts = jnp.bincount(flat_e, length=N_EXPERTS)
    starts = jnp.cumsum(counts) - counts
    padded = ((counts + MOE_BLOCK - 1) // MOE_BLOCK) * MOE_BLOCK
    padded_ends = jnp.cumsum(padded)
    padded_starts = padded_ends - padded
    dest = padded_starts[sorted_e] + (jnp.arange(A) - starts[sorted_e])
    rows_tok = jnp.full((P,), T, jnp.int32).at[dest].set(flat_tok[order])
    rows_w = jnp.zeros((P,), h.dtype).at[dest].set(flat_w[order])
    block_expert = jnp.clip(jnp.searchsorted(padded_ends, jnp.arange(NB) * MOE_BLOCK, side='right'),
                            0, N_EXPERTS - 1)
    h_pad = jnp.concatenate([ht, jnp.zeros((1, D), ht.dtype)], axis=0)
    xs = h_pad[rows_tok].reshape(NB, MOE_BLOCK, D)

    def expert_block(args):
        xb, e = args
        return (jax.nn.silu(xb @ w_gate[e]) * (xb @ w_up[e])) @ w_down[e]

    ys = lax.map(expert_block, (xs, block_expert)).reshape(P, D) * rows_w[:, None]
    out = jnp.zeros((T + 1, D), h.dtype).at[rows_tok].add(ys)[:T]
    return out.reshape(B, S, D)


def setup_inputs(seed: int = 0) -> dict:
    key = jax.random.key(seed)
    ks = iter(jax.random.split(key, 40))

    def nrm(shape, scale):
        return jax.random.normal(next(ks), shape, jnp.float32) * scale

    def gain(n):
        return 1.0 + 0.05 * jax.random.normal(next(ks), (n,), jnp.float32)

    D = D_MODEL
    return {
        "x": nrm((BATCH, SEQ, D), 1.0),
        "mem": nrm((BATCH, MEM_LEN, D), 1.0),
        "g_norm_mix": gain(D),
        "w_in": nrm((D, IN_WIDTH), D ** -0.5),
        "g_v": gain(GMLP_WIDTH),
        "b_v": nrm((GMLP_WIDTH,), 0.02),
        "w_spatial": nrm((GMLP_HEADS, CHUNK, CHUNK), 0.5 * CHUNK ** -0.5),
        "b_spatial": 1.0 + nrm((GMLP_HEADS, CHUNK), 0.02),
        "g_q_lora": gain(Q_LORA),
        "w_uq": nrm((Q_LORA, MLA_HEADS * (QK_NOPE + QK_ROPE)), Q_LORA ** -0.5),
        "g_kv_lora": gain(KV_LORA),
        "w_ukv": nrm((KV_LORA, MLA_HEADS * (QK_NOPE + V_DIM)), KV_LORA ** -0.5),
        "g_out_gmlp": gain(GMLP_WIDTH),
        "g_out_mla": gain(MLA_WIDTH),
        "w_out": nrm((MIX_WIDTH, D), MIX_WIDTH ** -0.5),
        "g_norm_xattn": gain(D),
        "g_norm_mem": gain(D),
        "w_mq": nrm((D, MEM_HEADS * MEM_HEAD_DIM), D ** -0.5),
        "w_mk": nrm((D, MEM_HEADS * MEM_HEAD_DIM), D ** -0.5),
        "w_mv": nrm((D, MEM_HEADS * MEM_HEAD_DIM), D ** -0.5),
        "w_mo": nrm((MEM_HEADS * MEM_HEAD_DIM, D), (MEM_HEADS * MEM_HEAD_DIM) ** -0.5),
        "g_norm_moe": gain(D),
        "w_router_group": nrm((D, N_GROUPS), D ** -0.5),
        "b_router_group": nrm((N_GROUPS,), 0.01),
        "w_router_expert": nrm((D, N_EXPERTS), D ** -0.5),
        "b_router_expert": nrm((N_EXPERTS,), 0.01),
        "w_exp_gate": nrm((N_EXPERTS, D, D_EXPERT), D ** -0.5),
        "w_exp_up": nrm((N_EXPERTS, D, D_EXPERT), D ** -0.5),
        "w_exp_down": nrm((N_EXPERTS, D_EXPERT, D), D_EXPERT ** -0.5),
        "g_final": gain(D),
    }


def reference(x, mem, g_norm_mix, w_in, g_v, b_v, w_spatial, b_spatial, g_q_lora, w_uq,
              g_kv_lora, w_ukv, g_out_gmlp, g_out_mla, w_out, g_norm_xattn, g_norm_mem,
              w_mq, w_mk, w_mv, w_mo, g_norm_moe, w_router_group, b_router_group,
              w_router_expert, b_router_expert, w_exp_gate, w_exp_up, w_exp_down, g_final):
    c1 = 2 * GMLP_WIDTH
    c2 = c1 + Q_LORA
    c3 = c2 + KV_LORA
    for _ in range(DEPTH):
        z = rms_norm(x, g_norm_mix) @ w_in
        a = gmlp_group(z[..., :c1], g_v, b_v, w_spatial, b_spatial)
        m = mla_group(z[..., c1:c2], z[..., c2:c3], z[..., c3:], g_q_lora, w_uq, g_kv_lora, w_ukv)
        merged = jnp.concatenate([rms_norm(a, g_out_gmlp), rms_norm(m, g_out_mla)], axis=-1)
        x = x + merged @ w_out
        x = x + memory_cross_attention(rms_norm(x, g_norm_xattn), rms_norm(mem, g_norm_mem),
                                       w_mq, w_mk, w_mv, w_mo)
        x = x + hierarchical_moe(rms_norm(x, g_norm_moe), w_router_group, b_router_group,
                                 w_router_expert, b_router_expert, w_exp_gate, w_exp_up, w_exp_down)
    return rms_norm(x, g_final)
```

```cpp
#include <hip/hip_runtime.h>
#include <cstdio>
#include <cstdint>

#define LAS __attribute__((address_space(3)))
#define GAS __attribute__((address_space(1)))
typedef unsigned short bf16_t;
typedef short bf16x8 __attribute__((ext_vector_type(8)));
typedef short s16x4 __attribute__((ext_vector_type(4)));
typedef float f32x2 __attribute__((ext_vector_type(2)));
typedef float f32x4 __attribute__((ext_vector_type(4)));
typedef float f32x16 __attribute__((ext_vector_type(16)));
typedef unsigned u32x2 __attribute__((ext_vector_type(2)));
typedef unsigned u32x4 __attribute__((ext_vector_type(4)));
typedef int i32x4 __attribute__((ext_vector_type(4)));
typedef int i32x8 __attribute__((ext_vector_type(8)));

constexpr int T = 16384, DM = 2048, SEQ = 2048, NBATCH = 8, MEMLEN = 256;
constexpr int INW = 2880, INWP = 3072, GW = 1024, QL = 512, KVL = 256, ROPE = 64;
constexpr int NQ = 1536, NKV = 2048, NEXP = 64, DE = 512, CAP = 16384;
constexpr float EPS = 1e-6f;

typedef __bf16 bf16x2_t __attribute__((ext_vector_type(2)));
__device__ __forceinline__ unsigned cvt_pk_bf16(float lo, float hi) { const f32x2 v = {lo, hi}; const bf16x2_t b = __builtin_convertvector(v, bf16x2_t); return __builtin_bit_cast(unsigned, b); }
__device__ __forceinline__ u32x4 pack8(const f32x4 a, const f32x4 b) { u32x4 w; w.x = cvt_pk_bf16(a[0], a[1]); w.y = cvt_pk_bf16(a[2], a[3]); w.z = cvt_pk_bf16(b[0], b[1]); w.w = cvt_pk_bf16(b[2], b[3]); return w; }
__device__ __forceinline__ u32x2 pack8_fp8(const f32x4 a, const f32x4 b) {
    int lo = __builtin_amdgcn_cvt_pk_fp8_f32(a[0], a[1], 0, false); lo = __builtin_amdgcn_cvt_pk_fp8_f32(a[2], a[3], lo, true);
    int hi = __builtin_amdgcn_cvt_pk_fp8_f32(b[0], b[1], 0, false); hi = __builtin_amdgcn_cvt_pk_fp8_f32(b[2], b[3], hi, true);
    return (u32x2){(unsigned)lo, (unsigned)hi};
}
__device__ __forceinline__ float bf_lo(unsigned w) { return __uint_as_float(w << 16); }
__device__ __forceinline__ float bf_hi(unsigned w) { return __uint_as_float(w & 0xffff0000u); }
__device__ __forceinline__ float gelu_tanh(float x) {
    const float u2 = 1.5957691216057308f * (x + 0.044715f * x * x * x);
    return x * __builtin_amdgcn_rcpf(1.0f + __builtin_amdgcn_exp2f(-1.4426950408889634f * u2));
}
__device__ __forceinline__ float silu_f(float x) { return x * __builtin_amdgcn_rcpf(1.0f + __builtin_amdgcn_exp2f(-1.4426950408889634f * x)); }
__device__ __forceinline__ float fq_reduce(float s) {
    { const auto r = __builtin_amdgcn_permlane16_swap(__float_as_uint(s), __float_as_uint(s), false, false); s = __uint_as_float(r[0]) + __uint_as_float(r[1]); }
    { const auto r = __builtin_amdgcn_permlane32_swap(__float_as_uint(s), __float_as_uint(s), false, false); s = __uint_as_float(r[0]) + __uint_as_float(r[1]); }
    return s;
}
__device__ __forceinline__ float wave_sum(float v) {
#pragma unroll
    for (int o = 1; o < 64; o <<= 1) v += __shfl_xor(v, o);
    return v;
}
typedef unsigned long long stat_t;
__device__ __forceinline__ void stat_add(stat_t* p, float v) { atomicAdd(p, (stat_t)(long long)(v * 4294967296.0f)); }
__device__ __forceinline__ float stat_get(const stat_t* p) { return (float)((double)(long long)(*p) * 2.3283064365386963e-10); }
__device__ __forceinline__ float rstd_of(float ssq, float inv_n) { return 1.0f / sqrtf(ssq * inv_n + EPS); }

namespace pg8 {
constexpr int BM = 256, BK = 64, HALF = 128, HTB = HALF * BK * 2, STAGE_BYTES = 8 * HTB, NXCD = 8, WGM = 8;
__host__ __device__ __forceinline__ int lds_byte(int r, int c) { const int st = (r >> 4) * 2 + (c >> 5), rr = r & 15, cc = c & 31, ob = rr * 64 + cc * 2; return st * 1024 + (ob ^ (((ob >> 9) & 1) << 5)); }
__host__ __device__ __forceinline__ void stage_rc(int b, int& R, int& C) { const int st = b / 1024, sb = b % 1024, swz = sb ^ (((sb >> 9) & 1) << 5); R = (st >> 1) * 16 + swz / 64; C = (st & 1) * 32 + (swz % 64) / 2; }
__host__ __device__ __forceinline__ int perm32(int rho) { const int n = rho >> 4, i = rho & 15; return 8 * (i >> 2) + 4 * n + (i & 3); }

struct Unit { int pm, pn, e, j; unsigned koff; int full; int roff; };
struct Gemm { const bf16_t* A; const bf16_t* Bt; int K, lda, ldb; };

struct StaticOrder {
    static constexpr bool LAZY_A = false, LINEAR_A = true;
    int nM, nN, nwg, G, c;
    __device__ void init(int M, int N, int G_, int c_) { nM = M / BM; nN = N / BM; nwg = nM * nN; G = G_; c = c_; }
    __device__ bool next(int i, Unit& u) const {
        const long L = (long)i * G + c; if (L >= nwg) return false;
        int wgid = (int)L; { const int q = nwg / NXCD, r = nwg % NXCD, xcd = wgid % NXCD, off = wgid / NXCD; wgid = (xcd < r ? xcd * (q + 1) : r * (q + 1) + (xcd - r) * q) + off; }
        const int nig = WGM * nN, gid = wgid / nig, fm = gid * WGM, gsz = (nM - fm) < WGM ? (nM - fm) : WGM;
        u.pm = fm + ((wgid % nig) % gsz); u.pn = (wgid % nig) / gsz; u.e = 0; u.j = 0; u.koff = 0u; u.full = 1; u.roff = 0; return true;
    }
    __device__ __forceinline__ int arow(const Unit& u, int r) const { return u.pm * BM + r; }
};

struct SubOrder {
    static constexpr bool LAZY_A = false, LINEAR_A = true;
    StaticOrder base; int i0, i1;
    __device__ bool next(int i, Unit& u) const { return (i0 + i < i1) && base.next(i0 + i, u); }
    __device__ __forceinline__ int arow(const Unit& u, int r) const { return u.pm * BM + r; }
};
__device__ __forceinline__ const char* uptr(const char* p) {
    const unsigned long long v = (unsigned long long)p;
    const unsigned lo = __builtin_amdgcn_readfirstlane((unsigned)v), hi = __builtin_amdgcn_readfirstlane((unsigned)(v >> 32));
    return (const char*)(((unsigned long long)hi << 32) | lo);
}
template <class E, class = void> struct EpiInit { static constexpr bool v = false; };
template <class E> struct EpiInit<E, decltype((void)E::ACCINIT)> { static constexpr bool v = E::ACCINIT; };
template <class E, class = void> struct EpiF8 { static constexpr bool v = false; };
template <class E> struct EpiF8<E, decltype((void)E::F8)> { static constexpr bool v = E::F8; };
__device__ __forceinline__ i32x8 cat8(const bf16x8 a, const bf16x8 b) { return __builtin_shufflevector(__builtin_bit_cast(i32x4, a), __builtin_bit_cast(i32x4, b), 0, 1, 2, 3, 4, 5, 6, 7); }
template <class Epi, class Sched>
__device__ __forceinline__ void gemm_phase(LAS unsigned char* lds, const Gemm g, const Sched& S, const Epi& E) {
    constexpr bool F8 = EpiF8<Epi>::v;
    int tid_ = threadIdx.x; asm volatile("" : "+v"(tid_));
    int tid = tid_; const int wid = __builtin_amdgcn_readfirstlane(tid >> 6), wr = wid >> 2, wc = wid & 3;
    int lane, fr, fq, aoff;
    const int dAB = wc * 4096 - wr * 8192;
    const int K = g.K, nt = K / BK;
    unsigned voffB0;
#define PG8_LANE() do { tid = (int)threadIdx.x; asm volatile("" : "+v"(tid)); lane = tid & 63; fr = lane & 15; fq = lane >> 4; \
    { int R, C; stage_rc(tid * 16, R, C); voffB0 = (unsigned)(((R & ~31) + perm32(R & 31)) * g.ldb + C) * 2u; } \
    aoff = lds_byte(wr * 64 + fr, fq * 8); } while (0)
    PG8_LANE();
    const unsigned rowb = (unsigned)g.lda * 2u;
    const size_t kstep = (size_t)(BK * 2);
    const size_t hstep = (size_t)HALF * g.ldb * 2;
    const size_t tstep = 2 * hstep;
    const unsigned ldsw = (unsigned)wid * 1024u;
    const size_t dB64 = (size_t)64 * g.ldb * 2, dA64 = (size_t)64 * g.lda * 2;
#define PG8_SA(b, h) (((b) * 2 + (h)) * HTB)
#define PG8_SB(b, h) ((4 + (b) * 2 + (h)) * HTB)
#define PG8_STAGE(bufoff, gbase, voff) do { const char* _gb = (const char*)(gbase); unsigned _vo = voffB0; asm volatile("" : "+s"(_gb), "+v"(_vo)); \
        __builtin_amdgcn_global_load_lds((const unsigned*)(_gb + _vo), (LAS unsigned*)(lds + (bufoff) + ldsw), 16, 0, 0); \
        __builtin_amdgcn_global_load_lds((const unsigned*)(_gb + dB64 + _vo), (LAS unsigned*)(lds + (bufoff) + ldsw + 8192), 16, 0, 0); } while (0)
#define PG8_STAGE_A2(bufoff, kbyte, h, oa0, oa1, ob0, ob1) do { unsigned _o0 = (Sched::LINEAR_A || !(h)) ? (oa0) : (ob0), _o1 = Sched::LINEAR_A ? 0u : ((h) ? (ob1) : (oa1)); \
        const char* _ab = (const char*)g.A + (kbyte) + (Sched::LINEAR_A && (h) ? 2 * dA64 : (size_t)0); asm volatile("" : "+v"(_o0), "+v"(_o1), "+s"(_ab)); \
        __builtin_amdgcn_global_load_lds((const unsigned*)(_ab + _o0), (LAS unsigned*)(lds + (bufoff) + ldsw), 16, 0, 0); \
        if constexpr (Sched::LINEAR_A) __builtin_amdgcn_global_load_lds((const unsigned*)(_ab + dA64 + _o0), (LAS unsigned*)(lds + (bufoff) + ldsw + 8192), 16, 0, 0); \
        else __builtin_amdgcn_global_load_lds((const unsigned*)(_ab + _o1), (LAS unsigned*)(lds + (bufoff) + ldsw + 8192), 16, 0, 0); } while (0)
#define PG8_LDA(dst, b, h) do { _Pragma("unroll") for (int m = 0; m < 4; ++m) _Pragma("unroll") for (int k = 0; k < 2; ++k) dst[m][k] = *(const LAS bf16x8*)(lds + PG8_SA(b, h) + aoff + m * 2048 + k * 1024); } while (0)
#define PG8_LDB(dst, b, h) do { int _bo = aoff; asm volatile("" : "+v"(_bo)); _bo += dAB; _Pragma("unroll") for (int n = 0; n < 2; ++n) _Pragma("unroll") for (int k = 0; k < 2; ++k) dst[n][k] = *(const LAS bf16x8*)(lds + PG8_SB(b, h) + _bo + n * 2048 + k * 1024); } while (0)
#define PG8_MMA(ai, bj, At, Bt) do { __builtin_amdgcn_s_setprio(1); _Pragma("unroll") for (int m = 0; m < 4; ++m) _Pragma("unroll") for (int n = 0; n < 2; ++n) { \
        if constexpr (F8) acc[ai][bj][m][n] = __builtin_amdgcn_mfma_scale_f32_16x16x128_f8f6f4(cat8(Bt[n][0], Bt[n][1]), cat8(At[m][0], At[m][1]), acc[ai][bj][m][n], 0, 0, 0, 0, 0, 0); \
        else { _Pragma("unroll") for (int k = 0; k < 2; ++k) acc[ai][bj][m][n] = __builtin_amdgcn_mfma_f32_16x16x32_bf16(Bt[n][k], At[m][k], acc[ai][bj][m][n], 0, 0, 0); } } __builtin_amdgcn_s_setprio(0); } while (0)
#define PG8_WAIT_V(n) asm volatile("s_waitcnt vmcnt(" #n ")" ::: "memory")
#define PG8_WAIT_L(n) asm volatile("s_waitcnt lgkmcnt(" #n ")" ::: "memory")
#define PG8_BAR __builtin_amdgcn_s_barrier()
#define PG8_SCHED __builtin_amdgcn_sched_barrier(0)
#define PG8_AOFFS(u, o00, o01, o10, o11) do { int _t = (int)threadIdx.x; asm volatile("" : "+v"(_t)); int RA0, _C; stage_rc(_t * 16, RA0, _C); const unsigned CA0 = (unsigned)_C * 2u;     \
        o00 = (unsigned)S.arow(u, RA0) * rowb + CA0 + (u).koff; \
        if constexpr (!Sched::LINEAR_A) { o10 = (unsigned)S.arow(u, HALF + RA0) * rowb + CA0 + (u).koff; o01 = (unsigned)S.arow(u, RA0 + 64) * rowb + CA0 + (u).koff; o11 = (unsigned)S.arow(u, HALF + RA0 + 64) * rowb + CA0 + (u).koff; } \
        else { o01 = 0u; o10 = 0u; o11 = 0u; } } while (0)
    Unit cur, nxt; int ui = 0;
    if (!S.next(0, cur)) return;
    f32x4 acc[2][2][4][2];
#pragma unroll
    for (int a = 0; a < 2; ++a)
#pragma unroll
        for (int b = 0; b < 2; ++b)
#pragma unroll
            for (int m = 0; m < 4; ++m)
#pragma unroll
                for (int n = 0; n < 2; ++n) acc[a][b][m][n] = (f32x4){0.f, 0.f, 0.f, 0.f};
    if constexpr (EpiInit<Epi>::v) E.init(acc, cur, wr, wc, fr, fq);
    bf16x8 At[4][2], B0[2][2], B1[2][2];
    unsigned ca00, ca01, ca10, ca11, na00, na01, na10, na11;
    PG8_AOFFS(cur, ca00, ca01, ca10, ca11);
#define PG8_TAB(par) ((LAS float*)(lds + STAGE_BYTES + ((par) & 1) * 4096))
    if constexpr (Epi::PREP) E.prep(cur, PG8_TAB(0), (int)threadIdx.x);
    const char* cB = uptr((const char*)g.Bt + (size_t)cur.pn * tstep + cur.koff);
    PG8_STAGE(PG8_SB(0, 0), cB, 0); PG8_STAGE(PG8_SB(0, 1), cB + hstep, 0); PG8_STAGE_A2(PG8_SA(0, 0), 0, 0, ca00, ca01, ca10, ca11); PG8_STAGE_A2(PG8_SA(0, 1), 0, 1, ca00, ca01, ca10, ca11);
    if (wr == 1) PG8_BAR;
    PG8_WAIT_V(2); PG8_BAR;
    PG8_STAGE(PG8_SB(1, 0), cB + kstep, 0); PG8_STAGE_A2(PG8_SA(1, 0), kstep, 0, ca00, ca01, ca10, ca11); PG8_STAGE(PG8_SB(1, 1), cB + hstep + kstep, 0);
    PG8_WAIT_V(6); PG8_BAR;
    for (;;) {
        const bool has_next = S.next(ui + 1, nxt);
        const char* nB = uptr(has_next ? (const char*)g.Bt + (size_t)nxt.pn * tstep + nxt.koff : cB);
        if constexpr (!Sched::LAZY_A) { if (has_next) { PG8_AOFFS(nxt, na00, na01, na10, na11); } else { na00 = ca00; na01 = ca01; na10 = ca10; na11 = ca11; } }
#pragma unroll 1
        for (int t = 0; t < nt; t += 2) {
            const bool last = (t == nt - 2);
            if constexpr (Epi::MID) { if (t == (nt >> 1)) E.mid(acc, cur, wr, fr, PG8_TAB(ui)); }
            const size_t kb1 = (size_t)(t + 1) * kstep;
            const size_t kb2 = last ? (size_t)0 : (size_t)(t + 2) * kstep, kb3 = kb2 + kstep;
            const char* b2 = last ? nB : cB + (size_t)(t + 2) * kstep; const char* b3 = b2 + kstep;
            unsigned s00 = ca00, s01 = ca01, s10 = ca10, s11 = ca11;
            if constexpr (Sched::LAZY_A) { if (last && has_next) { PG8_AOFFS(nxt, s00, s01, s10, s11); } }
            else { if (last) { s00 = na00; s01 = na01; s10 = na10; s11 = na11; } }
            PG8_LDB(B0, 0, 0); PG8_LDB(B1, 0, 1); PG8_SCHED; PG8_LDA(At, 0, 0); PG8_STAGE_A2(PG8_SA(1, 1), kb1, 1, ca00, ca01, ca10, ca11);
            PG8_WAIT_V(8); PG8_WAIT_L(0); PG8_BAR; PG8_MMA(0, 0, At, B0); PG8_MMA(0, 1, At, B1); PG8_BAR; PG8_SCHED;
            PG8_LDA(At, 0, 1); PG8_STAGE(PG8_SB(0, 0), b2, 0); PG8_STAGE(PG8_SB(0, 1), b2 + hstep, 0); PG8_STAGE_A2(PG8_SA(0, 0), kb2, 0, s00, s01, s10, s11);
            PG8_WAIT_V(8); PG8_WAIT_L(0); PG8_BAR; if (cur.full) { PG8_MMA(1, 0, At, B0); PG8_MMA(1, 1, At, B1); } PG8_BAR; PG8_SCHED;
            PG8_LDB(B0, 1, 0); PG8_LDB(B1, 1, 1); PG8_SCHED; PG8_LDA(At, 1, 0); PG8_STAGE_A2(PG8_SA(0, 1), kb2, 1, s00, s01, s10, s11);
            PG8_WAIT_V(8); PG8_WAIT_L(0); PG8_BAR; PG8_MMA(0, 0, At, B0); PG8_MMA(0, 1, At, B1); PG8_BAR; PG8_SCHED;
            PG8_LDA(At, 1, 1); PG8_STAGE(PG8_SB(1, 0), b3, 0); PG8_STAGE(PG8_SB(1, 1), b3 + hstep, 0); PG8_STAGE_A2(PG8_SA(1, 0), kb3, 0, s00, s01, s10, s11);
            PG8_WAIT_V(8); PG8_WAIT_L(0); PG8_BAR; if (cur.full) { PG8_MMA(1, 0, At, B0); PG8_MMA(1, 1, At, B1); } PG8_BAR; PG8_SCHED;
        }
        if (wr == 0) PG8_BAR;
        int l_e = (int)threadIdx.x & 63; asm volatile("" : "+v"(l_e)); const int fr_e = l_e & 15, fq_e = l_e >> 4;
        if constexpr (Epi::PREP) { E(acc, cur, wr, wc, fr_e, fq_e, PG8_TAB(ui)); if (has_next) E.prep(nxt, PG8_TAB(ui + 1), (int)threadIdx.x); }
        else if constexpr (!Epi::AFTER) E(acc, cur, wr, wc, fr_e, fq_e);
        if (!has_next) break;
#pragma unroll
        for (int a = 0; a < 2; ++a)
#pragma unroll
            for (int b = 0; b < 2; ++b)
#pragma unroll
                for (int m = 0; m < 4; ++m)
#pragma unroll
                    for (int n = 0; n < 2; ++n) acc[a][b][m][n] = (f32x4){0.f, 0.f, 0.f, 0.f};
        if constexpr (EpiInit<Epi>::v) E.init(acc, nxt, wr, wc, fr_e, fq_e);
        cur = nxt; cB = nB; ++ui;
        PG8_LANE();
        if constexpr (Sched::LAZY_A) { PG8_AOFFS(cur, ca00, ca01, ca10, ca11); } else { ca00 = na00; ca01 = na01; ca10 = na10; ca11 = na11; }
        if (wr == 1) PG8_BAR;
    }
    PG8_WAIT_V(0);
    PG8_BAR;
    if constexpr (Epi::AFTER) { const int l_a = (int)threadIdx.x & 63; E.after(acc, cur, wr, wc, l_a & 15, l_a >> 4, lds, (int)threadIdx.x); }
#undef PG8_LANE
#undef PG8_SA
#undef PG8_SB
#undef PG8_STAGE
#undef PG8_STAGE_A2
#undef PG8_LDA
#undef PG8_LDB
#undef PG8_MMA
#undef PG8_WAIT_V
#undef PG8_WAIT_L
#undef PG8_BAR
#undef PG8_SCHED
#undef PG8_AOFFS
#undef PG8_TAB
}
}
using pg8::Unit;

constexpr size_t MiB = 1u << 20;
constexpr size_t WS_CTL = 0, CTL_ZERO_BYTES = 2 * MiB;
constexpr int CW_BAR = 4096;
constexpr int CW_CNT = 8192;
constexpr int CW_STAT = 16384;
enum { ST_VSUM = 0, ST_VSQ, ST_Q, ST_KV, ST_A, ST_M, ST_X1, ST_X2, ST_N };
static_assert((size_t)CW_STAT * 4 + (size_t)ST_N * T * 8 <= CTL_ZERO_BYTES, "ctl");
constexpr size_t al(size_t x) { return (x + 4095) / 4096 * 4096; }
constexpr size_t WS_WIN = CTL_ZERO_BYTES;
constexpr size_t WS_WUQ = WS_WIN + al((size_t)INWP * DM * 2);
constexpr size_t WS_WUKV = WS_WUQ + al((size_t)NQ * QL * 2);
constexpr size_t WS_WOA = WS_WUKV + al((size_t)NKV * KVL * 2);
constexpr size_t WS_WOM = WS_WOA + al((size_t)DM * GW * 2);
constexpr size_t WS_WMQ = WS_WOM + al((size_t)DM * GW * 2);
constexpr size_t WS_WMKV = WS_WMQ + al((size_t)512 * DM * 2);
constexpr size_t WS_WMO = WS_WMKV + al((size_t)1024 * DM * 2);
constexpr size_t WS_WR = WS_WMO + al((size_t)DM * 512 * 2);
constexpr size_t WS_RB = WS_WR + al((size_t)256 * DM * 2);
constexpr size_t WS_COS = WS_RB + al(1024);
constexpr size_t WS_SIN = WS_COS + al((size_t)SEQ * 32 * 4);
constexpr size_t WS_WGU = WS_SIN + al((size_t)SEQ * 32 * 4);
constexpr size_t WS_X8 = WS_WGU + (size_t)NEXP * 1024 * DM;
constexpr size_t WS_WD = WS_WGU + al((size_t)NEXP * 1024 * DM * 2);
constexpr size_t WS_HB = WS_WD + al((size_t)NEXP * DM * DE * 2);
constexpr size_t WS_UV = WS_HB + al((size_t)(T + 1) * DM * 2);
constexpr size_t WS_KV = WS_UV + al((size_t)T * DM * 2);
constexpr size_t WS_YS = WS_UV;
constexpr size_t WS_LOGP = WS_UV;
constexpr size_t WS_Q = WS_KV + al((size_t)T * NKV * 2);
constexpr size_t WS_H = WS_UV + (size_t)49152 * DM * 2;
constexpr size_t WS_CQ = WS_Q + al((size_t)49152 * DE * 2);
constexpr size_t WS_CKV = WS_CQ + al((size_t)T * QL * 2);
constexpr size_t WS_KR = WS_CKV + al((size_t)T * KVL * 2);
constexpr size_t WS_AB = WS_KR + al((size_t)T * ROPE * 2);
constexpr size_t WS_MB = WS_AB + al((size_t)T * GW * 2);
constexpr size_t WS_MEMN = WS_MB + al((size_t)T * GW * 2);
constexpr size_t WS_MKV = WS_MEMN + al((size_t)NBATCH * MEMLEN * DM * 2);
constexpr size_t WS_XQ = WS_MKV + al((size_t)NBATCH * MEMLEN * 1024 * 2);
constexpr size_t WS_XO = WS_XQ + al((size_t)T * 512 * 2);
constexpr size_t WS_LOG = WS_XO + al((size_t)T * 512 * 2);
constexpr size_t WS_TOKW = WS_LOG + al((size_t)T * 128 * 4);
constexpr size_t WS_ROWTOK = WS_TOKW + al((size_t)T * 2 * 4);
constexpr size_t WS_TOKE = WS_ROWTOK + al((size_t)NEXP * CAP * 4);
constexpr size_t WS_WSPB = WS_TOKE + al((size_t)T * 2 * 4);
constexpr size_t WS_RSTDX = WS_WSPB + al((size_t)8 * 128 * 128 * 2);
constexpr size_t WS_GINV = WS_RSTDX + al((size_t)T * 4);
constexpr size_t WS_WMOB = WS_GINV + al((size_t)DM * 4);
constexpr size_t WS_W2T = WS_WMOB + al((size_t)512 * DM * 2);
constexpr size_t WS_END = WS_W2T + al((size_t)256 * 512 * 2);
constexpr size_t WS_LOG1 = WS_UV;
static_assert(WS_UV + (size_t)49152 * DM * 2 + (size_t)49152 * DE * 2 <= WS_UV + (size_t)T * DM * 2 * 2 + (size_t)49152 * DE * 2 + (size_t)T * (QL + KVL + ROPE + 2 * GW) * 2, "YS | H inside the dead UV..MB span");
static_assert((size_t)T * NQ * 2 <= (size_t)49152 * DE * 2, "H overlays Q");

constexpr int RING_BYTES = 131072, MISC_OFF = 143360, TS_OFF = 143360 + 512, LDS_BYTES = 147456;

#define XB_TMO      128
#define XB_XCNT(j)  (256  + 64 * (j))
#define XB_XSUB(j)  (1280 + 64 * (j))
#define XB_XGEN(j)  (2304 + 64 * (j))
#define XB_TOP      3328
#define XB_TOPGEN   3392
#define XCD_BAR_WORDS 3456
#define XB_SPIN_CAP (1u << 18)
__device__ __forceinline__ unsigned xb_ld(unsigned* p)              { return __hip_atomic_load(p, __ATOMIC_RELAXED, __HIP_MEMORY_SCOPE_AGENT); }
__device__ __forceinline__ unsigned xb_add(unsigned* p, unsigned v) { return __hip_atomic_fetch_add(p, v, __ATOMIC_RELAXED, __HIP_MEMORY_SCOPE_AGENT); }
__device__ __forceinline__ unsigned xb_xcc_id() { return (unsigned)__builtin_amdgcn_s_getreg((3 << 11) | 20) & 0xFu; }
#define XB_SPIN(cond, bar) do { unsigned _sp = 0; while (cond) { __builtin_amdgcn_s_sleep(1); \
    if ((++_sp & 255u) == 0u) { if (xb_ld(&(bar)[XB_TMO])) break; if (_sp > XB_SPIN_CAP) { atomicAdd(&(bar)[XB_TMO], 1u); break; } } } } while (0)
struct XcdBarrier { unsigned* bar; unsigned x; volatile LAS unsigned* st; };
__device__ __forceinline__ XcdBarrier xcd_barrier_post(unsigned* bar, volatile LAS unsigned* st) {
    XcdBarrier b; b.bar = bar; b.x = xb_xcc_id(); b.st = st;
    if (threadIdx.x == 0) (void)xb_add(&bar[XB_XCNT(b.x)], 1u);
    return b;
}
__device__ __forceinline__ void xcd_barrier_complete(unsigned* bar, unsigned x, unsigned& nloc, unsigned& nx) {
    const unsigned G = gridDim.x * gridDim.y * gridDim.z;
    unsigned sum, cnt, mine, sp = 0u;
    for (;;) {
        sum = 0u; cnt = 0u; mine = 0u;
#pragma unroll
        for (unsigned j = 0; j < 16; ++j) { const unsigned c = xb_ld(&bar[XB_XCNT(j)]); sum += c; cnt += (c > 0u) ? 1u : 0u; mine = (j == x) ? c : mine; }
        if (sum == G) break;
        __builtin_amdgcn_s_sleep(1);
        if ((++sp & 255u) == 0u) { if (xb_ld(&bar[XB_TMO])) break; if (sp > XB_SPIN_CAP) { atomicAdd(&bar[XB_TMO], 1u); break; } }
    }
    nloc = mine > 0u ? mine : 1u; nx = cnt > 0u ? cnt : 1u;
}
__device__ __forceinline__ void xcd_barrier(const XcdBarrier& b) {
    asm volatile("s_waitcnt vmcnt(0)" ::: "memory");
    __syncthreads();
    if (threadIdx.x == 0) {
        unsigned* bar = b.bar;
        __builtin_amdgcn_s_waitcnt(0);
        unsigned nloc = b.st[0], nx = b.st[1];
        if (nloc == 0u) { xcd_barrier_complete(bar, b.x, nloc, nx); b.st[0] = nloc; b.st[1] = nx; }
        const unsigned old = xb_add(&bar[XB_XSUB(b.x)], 1u);
        const unsigned gen = old / nloc;
        if (old + 1u == (gen + 1u) * nloc) {
            __builtin_amdgcn_fence(__ATOMIC_RELEASE, "agent");
            asm volatile("s_waitcnt vmcnt(0)" ::: "memory");
            const unsigned og = xb_add(&bar[XB_TOP], 1u);
            const unsigned tg = og / nx;
            if (og + 1u == (tg + 1u) * nx) xb_add(&bar[XB_TOPGEN], 1u);
            else XB_SPIN(xb_ld(&bar[XB_TOPGEN]) == tg, bar);
            __builtin_amdgcn_fence(__ATOMIC_ACQUIRE, "agent");
            xb_add(&bar[XB_XGEN(b.x)], 1u);
            asm volatile("s_waitcnt vmcnt(0)" ::: "memory");
        } else {
            XB_SPIN(xb_ld(&bar[XB_XGEN(b.x)]) == gen, bar);
            __builtin_amdgcn_fence(__ATOMIC_ACQUIRE, "agent");
            asm volatile("s_waitcnt vmcnt(0)" ::: "memory");
        }
    }
    __syncthreads();
}

struct Frame {
    LAS unsigned char* lds;
    int vcu, G;
    const float* in[30];
    float* out; unsigned char* ws;
    unsigned* ctl;
};
#define WSP(T_, off) ((T_*)(F.ws + (off)))
#define STAT(F, k) ((stat_t*)((F).ctl + CW_STAT) + (size_t)(k) * T)

#define EPI_ROWS_BEGIN _Pragma("unroll") for (int ai = 0; ai < 2; ++ai) _Pragma("unroll") for (int m = 0; m < 4; ++m) { const int rl = ai * 128 + wr * 64 + m * 16 + fr; const int row = u.pm * 256 + rl; (void)row;
#define EPI_ROWS_END }

struct EpiZ {
    static constexpr bool MID = false, AFTER = false, PREP = false;
    bf16_t *UV, *CQ, *CKV, *KR; stat_t *vsum, *vsq, *ssq_q, *ssq_kv; const float *cosT, *sinT;
    __device__ __forceinline__ void operator()(const f32x4 (&acc)[2][2][4][2], const Unit& u, int wr, int wc, int fr, int fq) const {
        const int pn = u.pn, cl = wc * 32 + 8 * fq;
        EPI_ROWS_BEGIN
            if (pn < 8) {
                float s1 = 0.f, s2 = 0.f;
#pragma unroll
                for (int bj = 0; bj < 2; ++bj) {
                    f32x4 v0 = acc[ai][bj][m][0], v1 = acc[ai][bj][m][1];
#pragma unroll
                    for (int k = 0; k < 4; ++k) { v0[k] = gelu_tanh(v0[k]); v1[k] = gelu_tanh(v1[k]); }
                    *(u32x4*)(UV + (size_t)row * DM + pn * 256 + bj * 128 + cl) = pack8(v0, v1);
#pragma unroll
                    for (int k = 0; k < 4; ++k) { s1 += v0[k] + v1[k]; s2 += v0[k] * v0[k] + v1[k] * v1[k]; }
                }
                if (pn >= 4) { s1 = fq_reduce(s1); s2 = fq_reduce(s2); if (fq == 0) { stat_add(vsum + row, s1); stat_add(vsq + row, s2); } }
            } else if (pn < 11) {
                float s2 = 0.f;
#pragma unroll
                for (int bj = 0; bj < 2; ++bj) {
                    const f32x4 v0 = acc[ai][bj][m][0], v1 = acc[ai][bj][m][1];
                    if (pn < 10) *(u32x4*)(CQ + (size_t)row * QL + (pn - 8) * 256 + bj * 128 + cl) = pack8(v0, v1);
                    else *(u32x4*)(CKV + (size_t)row * KVL + bj * 128 + cl) = pack8(v0, v1);
#pragma unroll
                    for (int k = 0; k < 4; ++k) s2 += v0[k] * v0[k] + v1[k] * v1[k];
                }
                s2 = fq_reduce(s2);
                if (fq == 0) stat_add((pn < 10 ? ssq_q : ssq_kv) + row, s2);
            } else if (wc < 2) {
                const int pos = row & (SEQ - 1), i0 = cl >> 1;
                const unsigned to = (unsigned)((pos * 32 + i0) * 4);
                const f32x4 cs = *(const f32x4*)((const char*)cosT + to), sn = *(const f32x4*)((const char*)sinT + to);
                const f32x4 v0 = acc[ai][0][m][0], v1 = acc[ai][0][m][1];
                f32x4 o0, o1;
                o0[0] = v0[0] * cs[0] - v0[1] * sn[0]; o0[1] = v0[1] * cs[0] + v0[0] * sn[0];
                o0[2] = v0[2] * cs[1] - v0[3] * sn[1]; o0[3] = v0[3] * cs[1] + v0[2] * sn[1];
                o1[0] = v1[0] * cs[2] - v1[1] * sn[2]; o1[1] = v1[1] * cs[2] + v1[0] * sn[2];
                o1[2] = v1[2] * cs[3] - v1[3] * sn[3]; o1[3] = v1[3] * cs[3] + v1[2] * sn[3];
                *(u32x4*)(KR + (size_t)row * ROPE + cl) = pack8(o0, o1);
            }
        EPI_ROWS_END
    }
};
struct EpiQ {
    static constexpr bool MID = false, AFTER = false, PREP = true;
    bf16_t* Q; const stat_t* ssq_q; const float *cosT, *sinT;
    __device__ __forceinline__ void prep(const Unit& u, LAS float* tab, int tid) const { if (tid < 256) tab[tid] = rstd_of(stat_get(ssq_q + u.pm * 256 + tid), 1.0f / QL); }
    __device__ __forceinline__ void operator()(const f32x4 (&acc)[2][2][4][2], const Unit& u, int wr, int wc, int fr, int fq, const LAS float* tab) const {
        EPI_ROWS_BEGIN
            const float rs = tab[rl];
            const int pos = row & (SEQ - 1);
#pragma unroll
            for (int bj = 0; bj < 2; ++bj) {
                const int c0 = u.pn * 256 + bj * 128 + wc * 32 + 8 * fq, dd = c0 % 192;
                f32x4 v0 = acc[ai][bj][m][0] * rs, v1 = acc[ai][bj][m][1] * rs;
                if (dd >= 128) {
                    const int i0 = (dd - 128) >> 1;
                    const unsigned to = (unsigned)((pos * 32 + i0) * 4);
                    const f32x4 cs = *(const f32x4*)((const char*)cosT + to), sn = *(const f32x4*)((const char*)sinT + to);
                    f32x4 o0, o1;
                    o0[0] = v0[0] * cs[0] - v0[1] * sn[0]; o0[1] = v0[1] * cs[0] + v0[0] * sn[0];
                    o0[2] = v0[2] * cs[1] - v0[3] * sn[1]; o0[3] = v0[3] * cs[1] + v0[2] * sn[1];
                    o1[0] = v1[0] * cs[2] - v1[1] * sn[2]; o1[1] = v1[1] * cs[2] + v1[0] * sn[2];
                    o1[2] = v1[2] * cs[3] - v1[3] * sn[3]; o1[3] = v1[3] * cs[3] + v1[2] * sn[3];
                    v0 = o0; v1 = o1;
                }
                *(u32x4*)(Q + (size_t)row * NQ + c0) = pack8(v0, v1);
            }
        EPI_ROWS_END
    }
};
struct EpiScaleBf16 {
    static constexpr bool MID = false, AFTER = false, PREP = true;
    bf16_t* O; int ldo; const stat_t* ssq; float inv_n;
    __device__ __forceinline__ void prep(const Unit& u, LAS float* tab, int tid) const { if (tid < 256) tab[tid] = ssq ? rstd_of(stat_get(ssq + u.pm * 256 + tid), inv_n) : 1.0f; }
    __device__ __forceinline__ void operator()(const f32x4 (&acc)[2][2][4][2], const Unit& u, int wr, int wc, int fr, int fq, const LAS float* tab) const {
        EPI_ROWS_BEGIN
            const float rs = tab[rl];
#pragma unroll
            for (int bj = 0; bj < 2; ++bj)
                *(u32x4*)(O + (size_t)row * ldo + u.pn * 256 + bj * 128 + wc * 32 + 8 * fq) = pack8(acc[ai][bj][m][0] * rs, acc[ai][bj][m][1] * rs);
        EPI_ROWS_END
    }
};
struct EpiScaleF8 {
    static constexpr bool MID = false, AFTER = false, PREP = false;
    unsigned char* O; int ldo; float scale;
    __device__ __forceinline__ void operator()(const f32x4 (&acc)[2][2][4][2], const Unit& u, int wr, int wc, int fr, int fq) const {
        EPI_ROWS_BEGIN
#pragma unroll
            for (int bj = 0; bj < 2; ++bj)
                *(u32x2*)(O + (size_t)row * ldo + u.pn * 256 + bj * 128 + wc * 32 + 8 * fq) = pack8_fp8(acc[ai][bj][m][0] * scale, acc[ai][bj][m][1] * scale);
        EPI_ROWS_END
    }
};
struct EpiMix {
    static constexpr bool MID = true, AFTER = false, PREP = true, ACCINIT = true;
    const float* rstdx; const stat_t* ssq_a; const stat_t* ssq_m; bf16_t* XB; stat_t* ssq_out;
    __device__ __forceinline__ void prep(const Unit& u, LAS float* tab, int tid) const {
        asm volatile("" : "+v"(tid));
        if (tid < 256) { const int row = u.pm * 256 + tid;
            const float ra = rstd_of(stat_get(ssq_a + row), 1.0f / GW), rm = rstd_of(stat_get(ssq_m + row), 1.0f / GW);
            *(LAS f32x4*)(tab + tid * 4) = (f32x4){ra / rm, rm, 0.f, 0.f}; }
    }
    __device__ __forceinline__ void init(f32x4 (&acc)[2][2][4][2], const Unit& u, int wr, int wc, int fr, int fq) const {
        const unsigned cb = (unsigned)(u.pn * 256 + wc * 32 + 8 * fq) * 2u;
#pragma unroll
        for (int ai = 0; ai < 2; ++ai)
#pragma unroll
            for (int m = 0; m < 4; ++m) {
                const int row = u.pm * 256 + ai * 128 + wr * 64 + m * 16 + fr;
                const float f = 1.0f / (rstdx[row] * rstd_of(stat_get(ssq_a + row), 1.0f / GW));
#pragma unroll
                for (int bj = 0; bj < 2; ++bj) {
                    const u32x4 w = *(const u32x4*)((const char*)XB + ((unsigned)row * (unsigned)(DM * 2) + cb + bj * 256u));
                    acc[ai][bj][m][0] = (f32x4){bf_lo(w.x), bf_hi(w.x), bf_lo(w.y), bf_hi(w.y)} * f;
                    acc[ai][bj][m][1] = (f32x4){bf_lo(w.z), bf_hi(w.z), bf_lo(w.w), bf_hi(w.w)} * f;
                }
            }
    }
    __device__ __forceinline__ void mid(f32x4 (&acc)[2][2][4][2], const Unit& u, int wr, int fr, const LAS float* tab) const {
#pragma unroll
        for (int ai = 0; ai < 2; ++ai)
#pragma unroll
            for (int m = 0; m < 4; ++m) { const float f = tab[(ai * 128 + wr * 64 + m * 16 + fr) * 4];
#pragma unroll
                for (int bj = 0; bj < 2; ++bj) { acc[ai][bj][m][0] *= f; acc[ai][bj][m][1] *= f; } }
    }
    __device__ __forceinline__ void operator()(const f32x4 (&acc)[2][2][4][2], const Unit& u, int wr, int wc, int fr, int fq, const LAS float* tab) const {
        const unsigned cb = (unsigned)(u.pn * 256 + wc * 32 + 8 * fq) * 2u;
        EPI_ROWS_BEGIN
            const float rs = tab[rl * 4 + 1];
            float s2 = 0.f;
#pragma unroll
            for (int bj = 0; bj < 2; ++bj) {
                const f32x4 v0 = acc[ai][bj][m][0] * rs, v1 = acc[ai][bj][m][1] * rs;
                *(u32x4*)((char*)XB + ((unsigned)row * (unsigned)(DM * 2) + cb + bj * 256u)) = pack8(v0, v1);
#pragma unroll
                for (int k = 0; k < 4; ++k) s2 += v0[k] * v0[k] + v1[k] * v1[k];
            }
            s2 = fq_reduce(s2); if (fq == 0) stat_add(ssq_out + row, s2);
        EPI_ROWS_END
    }
};
struct EpiResidB {
    static constexpr bool MID = false, AFTER = false, PREP = false, F8 = true, ACCINIT = true;
    bf16_t* XB; stat_t* ssq_out;
    __device__ __forceinline__ void init(f32x4 (&acc)[2][2][4][2], const Unit& u, int wr, int wc, int fr, int fq) const {
        const unsigned cb = (unsigned)(u.pn * 256 + wc * 32 + 8 * fq) * 2u;
#pragma unroll
        for (int ai = 0; ai < 2; ++ai)
#pragma unroll
            for (int m = 0; m < 4; ++m)
#pragma unroll
                for (int bj = 0; bj < 2; ++bj) {
                    const u32x4 w = *(const u32x4*)((const char*)XB + ((unsigned)(u.pm * 256 + ai * 128 + wr * 64 + m * 16 + fr) * (unsigned)(DM * 2) + cb + bj * 256u));
                    acc[ai][bj][m][0] = (f32x4){bf_lo(w.x), bf_hi(w.x), bf_lo(w.y), bf_hi(w.y)} * 2048.0f;
                    acc[ai][bj][m][1] = (f32x4){bf_lo(w.z), bf_hi(w.z), bf_lo(w.w), bf_hi(w.w)} * 2048.0f;
                }
    }
    __device__ __forceinline__ void operator()(const f32x4 (&acc)[2][2][4][2], const Unit& u, int wr, int wc, int fr, int fq) const {
        const unsigned cb = (unsigned)(u.pn * 256 + wc * 32 + 8 * fq) * 2u;
        EPI_ROWS_BEGIN
            float s2 = 0.f;
#pragma unroll
            for (int bj = 0; bj < 2; ++bj) {
                const f32x4 v0 = acc[ai][bj][m][0] * 0.00048828125f, v1 = acc[ai][bj][m][1] * 0.00048828125f;
                *(u32x4*)((char*)XB + ((unsigned)row * (unsigned)(DM * 2) + cb + bj * 256u)) = pack8(v0, v1);
#pragma unroll
                for (int k = 0; k < 4; ++k) s2 += v0[k] * v0[k] + v1[k] * v1[k];
            }
            s2 = fq_reduce(s2); if (fq == 0) stat_add(ssq_out + row, s2);
        EPI_ROWS_END
    }
};
struct EpiLog1 {
    static constexpr bool MID = false, AFTER = false, PREP = false;
    float* LOG1;
    __device__ __forceinline__ void operator()(const f32x4 (&acc)[2][2][4][2], const Unit& u, int wr, int wc, int fr, int fq) const {
        if (wc < 3) {
            float* base = LOG1 + wc * 32 + 8 * fq;
            EPI_ROWS_BEGIN
                *(f32x4*)(base + (size_t)row * 128) = acc[ai][0][m][0];
                *(f32x4*)(base + (size_t)row * 128 + 4) = acc[ai][0][m][1];
            EPI_ROWS_END
        }
    }
};
struct EpiRoute {
    static constexpr bool MID = false, AFTER = true, PREP = false, F8 = true;
    const float* LOG1; const stat_t* ssq_x2; const float* rbias; float* tokw; int* rowtok; int* toke; int* cnt;
    __device__ __forceinline__ void after(const f32x4 (&acc)[2][2][4][2], const Unit& u, int wr, int wc, int fr, int fq, LAS unsigned char* lds, int tid) const {
        LAS float* Lg = (LAS float*)lds;
        LAS int* hist = (LAS int*)(lds + 81920); LAS int* gbase = hist + 64;
        const int c0 = wc * 32 + 8 * fq;
        if (c0 < 72) {
            const f32x4 bb0 = *(const f32x4*)(rbias + c0), bb1 = *(const f32x4*)(rbias + c0 + 4);
            EPI_ROWS_BEGIN
                const float rs = rstd_of(stat_get(ssq_x2 + row), 1.0f / DM);
                const f32x4 l0 = *(const f32x4*)(LOG1 + (size_t)row * 128 + c0), l1 = *(const f32x4*)(LOG1 + (size_t)row * 128 + c0 + 4);
                *(LAS f32x4*)(Lg + rl * 72 + c0) = (l0 + acc[ai][0][m][0] * 0.00048828125f) * rs + bb0;
                *(LAS f32x4*)(Lg + rl * 72 + c0 + 4) = (l1 + acc[ai][0][m][1] * 0.00048828125f) * rs + bb1;
            EPI_ROWS_END
        }
        if (tid < 64) hist[tid] = 0;
        __syncthreads();
        int e0 = 0, e1 = 0, p0 = 0, p1 = 0; const int t = u.pm * 256 + tid;
        if (tid < 256) {
            const LAS float* lg = Lg + tid * 72;
            float g[8];
#pragma unroll
            for (int j = 0; j < 8; ++j) g[j] = lg[j];
            int grp = 0; float gm = g[0];
#pragma unroll
            for (int j = 1; j < 8; ++j) if (g[j] > gm) { gm = g[j]; grp = j; }
            float gs = 0.f;
#pragma unroll
            for (int j = 0; j < 8; ++j) gs += expf(g[j] - gm);
            const float p_grp = 1.0f / gs;
            float e[8];
#pragma unroll
            for (int j = 0; j < 8; ++j) e[j] = lg[8 + grp * 8 + j];
            int i0 = 0; float m0 = e[0];
#pragma unroll
            for (int j = 1; j < 8; ++j) if (e[j] > m0) { m0 = e[j]; i0 = j; }
            int i1 = -1; float m1 = -3.0e38f;
#pragma unroll
            for (int j = 0; j < 8; ++j) if (j != i0 && e[j] > m1) { m1 = e[j]; i1 = j; }
            const float r = expf(m1 - m0), w0 = 1.0f / (1.0f + r), w1 = r / (1.0f + r);
            e0 = grp * 8 + i0; e1 = grp * 8 + i1;
            tokw[t * 2] = p_grp * w0; tokw[t * 2 + 1] = p_grp * w1;
            p0 = __hip_atomic_fetch_add(hist + e0, 1, __ATOMIC_RELAXED, __HIP_MEMORY_SCOPE_WORKGROUP); p1 = __hip_atomic_fetch_add(hist + e1, 1, __ATOMIC_RELAXED, __HIP_MEMORY_SCOPE_WORKGROUP);
        }
        __syncthreads();
        if (tid < 64) { const int h = hist[tid]; gbase[tid] = h ? atomicAdd(cnt + tid, h) : 0; }
        __syncthreads();
        if (tid < 256) {
            const int q0 = gbase[e0] + p0, q1 = gbase[e1] + p1;
            rowtok[e0 * CAP + q0] = t * 2; rowtok[e1 * CAP + q1] = t * 2 + 1;
            toke[t * 2] = (e0 << 16) | q0; toke[t * 2 + 1] = (e1 << 16) | q1;
        }
    }
};
struct EpiGU {
    static constexpr bool MID = false, AFTER = false, PREP = true, F8 = true;
    unsigned char* H; const stat_t* ssq; const int* cnt; const int* rowtok;
    __device__ __forceinline__ void prep(const Unit& u, LAS float* tab, int tid) const {
        if (tid < 256) { const int idx = u.j * 256 + u.roff + tid; float rs = 0.f;
            if (idx < cnt[u.e] && (u.full || tid < 128)) { const int tok = rowtok[u.e * CAP + idx] >> 1; rs = rstd_of(stat_get(ssq + tok), 1.0f / DM); }
            tab[tid] = rs; }
    }
    __device__ __forceinline__ void operator()(const f32x4 (&acc)[2][2][4][2], const Unit& u, int wr, int wc, int fr, int fq, const LAS float* tab) const {
        const int pnl = u.pn & 3;
#pragma unroll
        for (int ai = 0; ai < 2; ++ai) {
            if (ai == 1 && !u.full) continue;
#pragma unroll
            for (int mp = 0; mp < 2; ++mp) {
                u32x2 pk[2];
#pragma unroll
                for (int ms = 0; ms < 2; ++ms) {
                    const int m = 2 * mp + ms;
                    const float rs = tab[ai * 128 + wr * 64 + m * 16 + fr] * 0.00390625f, rs8 = rs * 8.0f;
                    f32x4 h0, h1;
#pragma unroll
                    for (int k = 0; k < 4; ++k) { h0[k] = __builtin_amdgcn_fmed3f(silu_f(acc[ai][0][m][0][k] * rs) * (acc[ai][1][m][0][k] * rs8), -440.f, 440.f);
                                                  h1[k] = __builtin_amdgcn_fmed3f(silu_f(acc[ai][0][m][1][k] * rs) * (acc[ai][1][m][1][k] * rs8), -440.f, 440.f); }
                    pk[ms] = pack8_fp8(h0, h1);
                }
                const int row = u.pm * 256 + ai * 128 + wr * 64 + (2 * mp + (fq & 1)) * 16 + fr;
                const auto rx = __builtin_amdgcn_permlane16_swap(pk[0].x, pk[1].x, false, false), ry = __builtin_amdgcn_permlane16_swap(pk[0].y, pk[1].y, false, false);
                *(u32x4*)(H + (size_t)(row + u.roff) * DE + pnl * 128 + wc * 32 + 8 * (fq & ~1)) = (u32x4){rx[0], ry[0], rx[1], ry[1]};
            }
        }
    }
};
struct EpiDown {
    static constexpr bool MID = false, AFTER = false, PREP = false, F8 = true;
    unsigned char* YS;
    __device__ __forceinline__ void operator()(const f32x4 (&acc)[2][2][4][2], const Unit& u, int wr, int wc, int fr, int fq) const {
        const int pnl = u.pn & 7;
#pragma unroll
        for (int ai = 0; ai < 2; ++ai) {
            if (ai == 1 && !u.full) continue;
#pragma unroll
            for (int mp = 0; mp < 2; ++mp) {
                const int row = u.pm * 256 + ai * 128 + wr * 64 + (2 * mp + (fq & 1)) * 16 + fr;
#pragma unroll
                for (int bj = 0; bj < 2; ++bj) {
                    constexpr float SC = 0.0009765625f;
                    const u32x2 a = pack8_fp8(acc[ai][bj][2 * mp][0] * SC, acc[ai][bj][2 * mp][1] * SC), b = pack8_fp8(acc[ai][bj][2 * mp + 1][0] * SC, acc[ai][bj][2 * mp + 1][1] * SC);
                    const auto rx = __builtin_amdgcn_permlane16_swap(a.x, b.x, false, false), ry = __builtin_amdgcn_permlane16_swap(a.y, b.y, false, false);
                    *(u32x4*)(YS + (size_t)row * DM + pnl * 256 + bj * 128 + wc * 32 + 8 * (fq & ~1)) = (u32x4){rx[0], ry[0], rx[1], ry[1]};
                }
            }
        }
    }
};
struct MoeOrder {
    static constexpr bool LAZY_A = false, LINEAR_A = false;
    const LAS int* ts; const int* cnt; const int* rowtok; int npn, G, c; bool gather; bool split;
    __device__ bool next(int i, Unit& u) const {
        const int L = i * G + c, nfu = ts[80 + NEXP] * npn, nhu = ts[160 + NEXP] * npn;
        int Lf = -1, Lh = -1, full = 1, roff = 0;
        if (!split) { if (L < nfu) Lf = L; else if (L - nfu < nhu) { Lh = L - nfu; full = 0; } else return false; }
        else { const int F0 = (nfu / G) * G, R = nfu - F0;
            if (L < F0) Lf = L;
            else { const int Lq = L - F0; if (Lq < 2 * R) { Lf = F0 + (Lq >> 1); full = 0; roff = (Lq & 1) * 128; } else if (Lq - 2 * R < nhu) { Lh = Lq - 2 * R; full = 0; } else return false; } }
        const int lane = threadIdx.x & 63;
        int e, pn, j;
        if (Lf >= 0) {
            const unsigned long long mk = __ballot(Lf >= ts[80 + lane] * npn && Lf < ts[80 + lane + 1] * npn);
            e = __builtin_amdgcn_readfirstlane(__builtin_ctzll(mk));
            const int nfe = ts[80 + e + 1] - ts[80 + e], loc = Lf - ts[80 + e] * npn; pn = loc / nfe; j = loc - pn * nfe;
        } else {
            const int ih = Lh / npn; pn = Lh - ih * npn;
            const unsigned long long mk = __ballot(ih >= ts[160 + lane] && ih < ts[160 + lane + 1]);
            e = __builtin_amdgcn_readfirstlane(__builtin_ctzll(mk));
            j = ts[80 + e + 1] - ts[80 + e];
        }
        u.e = e; u.j = j; u.pm = ts[e] + j; u.pn = e * npn + pn; u.koff = 0u; u.full = full; u.roff = roff;
        return true;
    }
    __device__ __forceinline__ int arow(const Unit& u, int r) const {
        if (!gather) return u.pm * 256 + r;
        const int idx = u.j * 256 + u.roff + r;
        return (idx < cnt[u.e] && (u.full || r < 128)) ? (rowtok[u.e * CAP + idx] >> 1) : T;
    }
};

namespace att {
#define KSWZ(row, colB) ((row) * 256 + ((colB) ^ (((row) & 7) << 4)))
#define KRSWZ(row, colB) ((row) * 128 + ((colB) ^ (((row) & 7) << 4)))
#define SBAR() __builtin_amdgcn_sched_barrier(0)
constexpr int SHM_V = 64 * 128 * 2, SHM_K = 64 * 128 * 2, SHM_KR = 64 * 64 * 2;
constexpr int OFF_V = 0, OFF_K = 2 * SHM_V, OFF_KR = OFF_K + 2 * SHM_K, OFF_WS = OFF_KR + 2 * SHM_KR, OFF_QR = OFF_WS + 8 * 64 * 4, ATT_LDS = OFF_QR + 8 * 4096;
__device__ __forceinline__ int crow(int r, int hi) { return (r & 3) + 8 * (r >> 2) + 4 * hi; }
__device__ __forceinline__ int v_st(int k, int c) { const int kk = (k & ~0xC) | ((k & 4) << 1) | ((k & 8) >> 1); return ((kk >> 3) * 4 + (c >> 5)) * 512 + ((kk & 7) * 32 + (c & 31)) * 2; }
__device__ __forceinline__ int v_rd_base(int lane) { return ((lane & 3) << 3) | (((lane >> 2) & 3) << 6) | (((lane >> 4) & 1) << 5) | (((lane >> 5) & 1) << 8); }
constexpr int v_rd_off(int d0, int ks, int half) { return d0 * 512 + ks * 4096 + half * 2048; }
template <int OFF> __device__ __forceinline__ s16x4 tr_read(int vb) { s16x4 r; asm volatile("ds_read_b64_tr_b16 %0, %1 offset:%2" : "=&v"(r) : "v"(vb), "i"(OFF) : "memory"); return r; }
template <int D0> __device__ __forceinline__ void pv_one(f32x16& od, int vb, bf16x8 pa0, bf16x8 pa1, bf16x8 pa2, bf16x8 pa3) {
    const s16x4 l0 = tr_read<v_rd_off(D0, 0, 0)>(vb), h0 = tr_read<v_rd_off(D0, 0, 1)>(vb), l1 = tr_read<v_rd_off(D0, 1, 0)>(vb), h1 = tr_read<v_rd_off(D0, 1, 1)>(vb);
    const s16x4 l2 = tr_read<v_rd_off(D0, 2, 0)>(vb), h2 = tr_read<v_rd_off(D0, 2, 1)>(vb), l3 = tr_read<v_rd_off(D0, 3, 0)>(vb), h3 = tr_read<v_rd_off(D0, 3, 1)>(vb);
    asm volatile("s_waitcnt lgkmcnt(0)" ::: "memory"); SBAR();
#define PK(L, Hh) (bf16x8){L[0], L[1], L[2], L[3], Hh[0], Hh[1], Hh[2], Hh[3]}
    od = __builtin_amdgcn_mfma_f32_32x32x16_bf16(pa0, PK(l0, h0), od, 0, 0, 0);
    od = __builtin_amdgcn_mfma_f32_32x32x16_bf16(pa1, PK(l1, h1), od, 0, 0, 0);
    od = __builtin_amdgcn_mfma_f32_32x32x16_bf16(pa2, PK(l2, h2), od, 0, 0, 0);
    od = __builtin_amdgcn_mfma_f32_32x32x16_bf16(pa3, PK(l3, h3), od, 0, 0, 0);
#undef PK
}
__device__ __forceinline__ void pv_d0(f32x16* o, int vb, bf16x8 pa0, bf16x8 pa1, bf16x8 pa2, bf16x8 pa3) {
    pv_one<0>(o[0], vb, pa0, pa1, pa2, pa3); pv_one<1>(o[1], vb, pa0, pa1, pa2, pa3); pv_one<2>(o[2], vb, pa0, pa1, pa2, pa3); pv_one<3>(o[3], vb, pa0, pa1, pa2, pa3);
}
template <int DR> struct Sc { static constexpr float SCALE = DR ? 0.07216878364870322f : 0.08838834764831845f; };
template <int DR> __device__ __forceinline__ void partialSM(f32x16& p0, f32x16& p1, float& m_reg, float& mn, float& alpha) {
    constexpr float SCALE = Sc<DR>::SCALE, C = SCALE * 1.4426950408889634f, THR = 8.f;
    float pmax = p0[0];
#pragma unroll
    for (int r = 1; r < 16; ++r) pmax = fmaxf(pmax, p0[r]);
#pragma unroll
    for (int r = 0; r < 16; ++r) pmax = fmaxf(pmax, p1[r]);
    { auto rr = __builtin_amdgcn_permlane32_swap(__float_as_uint(pmax), __float_as_uint(pmax), false, false); pmax = fmaxf(__uint_as_float(rr[0]), __uint_as_float(rr[1])); }
    if (__builtin_expect(__all(pmax - m_reg <= THR / SCALE), 1)) { mn = m_reg; alpha = 1.f; }
    else { mn = fmaxf(m_reg, pmax); alpha = __builtin_amdgcn_exp2f((m_reg - mn) * C); m_reg = mn; }
    const float mnC = -mn * C;
#pragma unroll
    for (int r = 0; r < 16; ++r) p0[r] = fmaf(p0[r], C, mnC);
#pragma unroll
    for (int r = 0; r < 16; ++r) p1[r] = fmaf(p1[r], C, mnC);
#pragma unroll
    for (int r = 0; r < 16; ++r) p0[r] = __builtin_amdgcn_exp2f(p0[r]);
}
__device__ __forceinline__ void finishSM(f32x16& p0, f32x16& p1, float alpha, float& l_reg, bf16x8& pa0, bf16x8& pa1, bf16x8& pa2, bf16x8& pa3) {
#pragma unroll
    for (int r = 0; r < 16; ++r) p1[r] = __builtin_amdgcn_exp2f(p1[r]);
    float ps = 0;
#pragma unroll
    for (int r = 0; r < 16; ++r) ps += p0[r];
#pragma unroll
    for (int r = 0; r < 16; ++r) ps += p1[r];
    { auto rr = __builtin_amdgcn_permlane32_swap(__float_as_uint(ps), __float_as_uint(ps), false, false); ps = __uint_as_float(rr[0]) + __uint_as_float(rr[1]); }
    l_reg = l_reg * alpha + ps;
#define PK4(P, BASE, OUT) do { unsigned a0 = cvt_pk_bf16(P[BASE + 0], P[BASE + 1]), a1 = cvt_pk_bf16(P[BASE + 2], P[BASE + 3]);   \
    unsigned b0 = cvt_pk_bf16(P[BASE + 4], P[BASE + 5]), b1 = cvt_pk_bf16(P[BASE + 6], P[BASE + 7]);                              \
    auto r0 = __builtin_amdgcn_permlane32_swap(a0, b0, false, false); auto r1 = __builtin_amdgcn_permlane32_swap(a1, b1, false, false); \
    u32x4 w = {r0[0], r1[0], r0[1], r1[1]}; OUT = *reinterpret_cast<bf16x8*>(&w); } while (0)
    PK4(p0, 0, pa0); PK4(p0, 8, pa1); PK4(p1, 0, pa2); PK4(p1, 8, pa3);
#undef PK4
}
template <int DR> __device__ __forceinline__ void qkt(f32x16& p0, f32x16& p1, const char* Ks, const char* Krs, const bf16x8* qr, const char* qrl, int r32, int hi) {
    p0 = f32x16{}; p1 = f32x16{};
#pragma unroll
    for (int d0 = 0; d0 < 8; ++d0) { const int cb = (d0 * 16 + hi * 8) * 2;
        const bf16x8 b0 = *reinterpret_cast<const bf16x8*>(Ks + KSWZ(r32, cb));
        const bf16x8 b1 = *reinterpret_cast<const bf16x8*>(Ks + KSWZ(32 + r32, cb));
        p0 = __builtin_amdgcn_mfma_f32_32x32x16_bf16(b0, qr[d0], p0, 0, 0, 0);
        p1 = __builtin_amdgcn_mfma_f32_32x32x16_bf16(b1, qr[d0], p1, 0, 0, 0); }
    if (DR) {
#pragma unroll
        for (int d0 = 0; d0 < DR / 16; ++d0) { const int cb = (d0 * 16 + hi * 8) * 2;
            const bf16x8 b0 = *reinterpret_cast<const bf16x8*>(Krs + KRSWZ(r32, cb));
            const bf16x8 b1 = *reinterpret_cast<const bf16x8*>(Krs + KRSWZ(32 + r32, cb));
            const bf16x8 qf = *reinterpret_cast<const bf16x8*>(qrl + d0 * 1024);
            p0 = __builtin_amdgcn_mfma_f32_32x32x16_bf16(b0, qf, p0, 0, 0, 0);
            p1 = __builtin_amdgcn_mfma_f32_32x32x16_bf16(b1, qf, p1, 0, 0, 0); }
    }
}
__device__ __forceinline__ void cmask(f32x16& p0, f32x16& p1, int kv0, int qrel, int hi) {
#pragma unroll
    for (int r = 0; r < 16; ++r) { const int kv = kv0 + (r & 3) + 8 * (r >> 2) + 4 * hi; if (kv > qrel) p0[r] = -1e30f; if (kv + 32 > qrel) p1[r] = -1e30f; }
}
template <int DR, bool CAUSAL, int LDQ, int LDK, int LDO, bool O8 = false>
__device__ __forceinline__ void attn_unit(const bf16_t* __restrict__ Qb, const bf16_t* __restrict__ Kn, const bf16_t* __restrict__ Vh, const bf16_t* __restrict__ Kr,
                                          bf16_t* __restrict__ Ob, const int NT, stat_t* ssq, char* lds) {
    int tid_ = threadIdx.x; asm volatile("" : "+v"(tid_));
    const int tid = tid_, wid = tid >> 6, lane = tid & 63, r32 = lane & 31, hi = lane >> 5;
    char* V_lds = lds + OFF_V; char* K_lds = lds + OFF_K; char* KR_lds = lds + OFF_KR;
    float* ws = (float*)(lds + OFF_WS) + wid * 64; float* li_l = ws; float* al_l = ws + 32;
    float m_reg = -1e30f, l_reg = 0; f32x16 o[4] = {}; bf16x8 qr[8];
    const char* qrl = lds + OFF_QR + wid * 4096 + lane * 16;
    const bf16_t* Qw = Qb + (long)(wid * 32 + r32) * LDQ + hi * 8;
#pragma unroll
    for (int d0 = 0; d0 < 8; ++d0) qr[d0] = *reinterpret_cast<const bf16x8*>(Qw + d0 * 16);
    if (DR) {
#pragma unroll
        for (int d0 = 0; d0 < DR / 16; ++d0) *(bf16x8*)(lds + OFF_QR + wid * 4096 + lane * 16 + d0 * 1024) = *reinterpret_cast<const bf16x8*>(Qw + 128 + d0 * 16);
    }
    const int sr = tid >> 4, sc = (tid & 15) * 8, vst0 = v_st(sr, sc), vst1 = v_st(32 + sr, sc);
    const int krr = tid >> 3, krc = (tid & 7) * 8;
    const int vb0 = (int)(uintptr_t)V_lds + v_rd_base(lane);
    bf16x8 vs0, vs1, ks0, ks1, krs;
    const unsigned vo0 = (unsigned)((sr * LDK + sc) * 2), vo1 = vo0 + 32u * LDK * 2u, kro = (unsigned)((krr * ROPE + krc) * 2);
#define SLOAD(k0) do { const char* vt_ = (const char*)Vh + (size_t)(k0) * (LDK * 2); const char* kt_ = (const char*)Kn + (size_t)(k0) * (LDK * 2); \
    vs0 = *reinterpret_cast<const bf16x8*>(vt_ + vo0); vs1 = *reinterpret_cast<const bf16x8*>(vt_ + vo1); \
    ks0 = *reinterpret_cast<const bf16x8*>(kt_ + vo0); ks1 = *reinterpret_cast<const bf16x8*>(kt_ + vo1); \
    if (DR) krs = *reinterpret_cast<const bf16x8*>((const char*)Kr + (size_t)(k0) * (ROPE * 2) + kro); } while (0)
#define SWRITE(b) do { *(bf16x8*)(V_lds + (b) * SHM_V + vst0) = vs0; *(bf16x8*)(V_lds + (b) * SHM_V + vst1) = vs1; const int kc = sc * 2; \
    *(bf16x8*)(K_lds + (b) * SHM_K + KSWZ(sr, kc)) = ks0; *(bf16x8*)(K_lds + (b) * SHM_K + KSWZ(32 + sr, kc)) = ks1; \
    if (DR) *(bf16x8*)(KR_lds + (b) * SHM_KR + KRSWZ(krr, krc * 2)) = krs; } while (0)
#define RESC(a) do { if (__any((a) < 1.f)) { if (hi == 0) al_l[r32] = (a); asm volatile("s_waitcnt lgkmcnt(0)" ::: "memory"); \
    _Pragma("unroll") for (int d = 0; d < 4; ++d) _Pragma("unroll") for (int r = 0; r < 16; ++r) o[d][r] *= al_l[crow(r, hi)]; } } while (0)
#define CM(P0, P1, jt) do { if (CAUSAL && (jt) >= NT - 4) cmask(P0, P1, ((jt) - (NT - 4)) * 64, wid * 32 + r32, hi); } while (0)
    f32x16 pA0, pA1, pB0, pB1; float mnA, mnB, alA, alB; bf16x8 pa0, pa1, pa2, pa3;
    SLOAD(0); asm volatile("s_waitcnt vmcnt(0)" ::: "memory"); SWRITE(0); __syncthreads();
    qkt<DR>(pA0, pA1, K_lds, KR_lds, qr, qrl, r32, hi); CM(pA0, pA1, 0); partialSM<DR>(pA0, pA1, m_reg, mnA, alA);
    SLOAD(64);
    asm volatile("s_waitcnt vmcnt(0)" ::: "memory"); SWRITE(1); __syncthreads();
    for (int j = 1; j + 1 < NT; j += 2) {
        SBAR(); qkt<DR>(pB0, pB1, K_lds + SHM_K, KR_lds + SHM_KR, qr, qrl, r32, hi); CM(pB0, pB1, j);
        finishSM(pA0, pA1, alA, l_reg, pa0, pa1, pa2, pa3); SBAR();
        SLOAD((j + 1) * 64); SBAR();
        pv_d0(o, vb0, pa0, pa1, pa2, pa3); partialSM<DR>(pB0, pB1, m_reg, mnB, alB);
        __syncthreads(); asm volatile("s_waitcnt vmcnt(0)" ::: "memory"); SWRITE(0);
        RESC(alB); __syncthreads();
        SBAR(); qkt<DR>(pA0, pA1, K_lds, KR_lds, qr, qrl, r32, hi); CM(pA0, pA1, j + 1);
        finishSM(pB0, pB1, alB, l_reg, pa0, pa1, pa2, pa3); SBAR();
        SLOAD((j + 2) * 64); SBAR();
        pv_d0(o, vb0 + SHM_V, pa0, pa1, pa2, pa3); partialSM<DR>(pA0, pA1, m_reg, mnA, alA);
        __syncthreads(); asm volatile("s_waitcnt vmcnt(0)" ::: "memory"); SWRITE(1);
        RESC(alA); __syncthreads();
    }
    SBAR(); qkt<DR>(pB0, pB1, K_lds + SHM_K, KR_lds + SHM_KR, qr, qrl, r32, hi); CM(pB0, pB1, NT - 1);
    finishSM(pA0, pA1, alA, l_reg, pa0, pa1, pa2, pa3); SBAR();
    pv_d0(o, vb0, pa0, pa1, pa2, pa3); partialSM<DR>(pB0, pB1, m_reg, mnB, alB);
    __syncthreads(); RESC(alB);
    finishSM(pB0, pB1, alB, l_reg, pa0, pa1, pa2, pa3); SBAR();
    pv_d0(o, vb0 + SHM_V, pa0, pa1, pa2, pa3);
    if (hi == 0) li_l[r32] = l_reg; asm volatile("s_waitcnt lgkmcnt(0)" ::: "memory");
    bf16_t* Op = O8 ? (bf16_t*)((unsigned char*)Ob + (long)(wid * 32 + 4 * hi) * LDO + r32) : Ob + (long)(wid * 32 + 4 * hi) * LDO + r32; stat_t* sp = ssq + wid * 32 + 4 * hi;
    asm volatile("" : "+v"(Op), "+v"(sp));
#pragma unroll
    for (int r = 0; r < 16; ++r) { const int orl = (r & 3) + 8 * (r >> 2); const float rli = __builtin_amdgcn_rcpf(li_l[orl + 4 * hi]); float s2 = 0.f;
#pragma unroll
        for (int d0 = 0; d0 < 4; ++d0) { const float v = o[d0][r] * rli; s2 += v * v;
            if constexpr (O8) ((GAS unsigned char*)Op)[orl * LDO + d0 * 32] = (unsigned char)(__builtin_amdgcn_cvt_pk_fp8_f32(v * 16.0f, 0.f, 0, false) & 0xff);
            else ((GAS bf16_t*)Op)[orl * LDO + d0 * 32] = (bf16_t)(cvt_pk_bf16(v, 0.f) & 0xffffu); }
        if (ssq) {
#pragma unroll
            for (int of = 1; of < 32; of <<= 1) s2 += __shfl_xor(s2, of);
            if (r32 == 0) (void)__hip_atomic_fetch_add((GAS stat_t*)sp + orl, (stat_t)(long long)(s2 * 4294967296.0f), __ATOMIC_RELAXED, __HIP_MEMORY_SCOPE_AGENT);
        }
    }
    __syncthreads();
#undef SLOAD
#undef SWRITE
#undef RESC
#undef CM
}
#undef SBAR
}

struct TrGeo { int nblk, per, K, N; };
__device__ __forceinline__ void tr_load(const float* W, const TrGeo& G, int it, int lane, f32x4 (&v)[16]) {
    const int e = it / G.per, r = it - e * G.per, kb = r / G.nblk, nb = r - kb * G.nblk;
    const float* src = W + (size_t)e * G.K * G.N + (size_t)(64 * kb + (lane >> 4)) * G.N + 64 * nb + (lane & 15) * 4;
#pragma unroll
    for (int i = 0; i < 16; ++i) v[i] = *(const f32x4*)(src + (size_t)(4 * i) * G.N);
}
template <class RowMap>
__device__ __forceinline__ void tr_store(const TrGeo& G, int it, int lane, const f32x4 (&v)[16], const float* gain, bf16_t* WT, const RowMap& rm, LAS float* scr, int ldt) {
    const int e = it / G.per, r = it - e * G.per, kb = r / G.nblk, nb = r - kb * G.nblk, k0 = 64 * kb, n0 = 64 * nb;
    const int lk = lane >> 4, ln4 = (lane & 15) * 4, c = lane >> 3, ns = lane & 7;
    f32x4 g0 = {1.f, 1.f, 1.f, 1.f}, g1 = {1.f, 1.f, 1.f, 1.f};
    if (gain) { g0 = *(const f32x4*)(gain + k0 + 8 * c); g1 = *(const f32x4*)(gain + k0 + 8 * c + 4); }
#pragma unroll
    for (int i = 0; i < 16; ++i) { LAS float* d = scr + (4 * i + lk) * 65 + ln4; d[0] = v[i].x; d[1] = v[i].y; d[2] = v[i].z; d[3] = v[i].w; }
    asm volatile("s_waitcnt lgkmcnt(0)" ::: "memory");
#pragma unroll
    for (int j = 0; j < 8; ++j) { const int n = ns + 8 * j; const LAS float* q = scr + (8 * c) * 65 + n;
        u32x4 o; o.x = cvt_pk_bf16(q[0 * 65] * g0.x, q[1 * 65] * g0.y); o.y = cvt_pk_bf16(q[2 * 65] * g0.z, q[3 * 65] * g0.w);
        o.z = cvt_pk_bf16(q[4 * 65] * g1.x, q[5 * 65] * g1.y); o.w = cvt_pk_bf16(q[6 * 65] * g1.z, q[7 * 65] * g1.w);
        *(u32x4*)(WT + (size_t)rm(e, n0 + n) * ldt + k0 + 8 * c) = o; }
    asm volatile("s_waitcnt lgkmcnt(0)" ::: "memory");
}
template <class RowMap>
__device__ __forceinline__ void tr_store8(const TrGeo& G, int it, int lane, const f32x4 (&v)[16], const float* gain, float scale, unsigned char* WT, const RowMap& rm, LAS float* scr, int ldt) {
    const int e = it / G.per, r = it - e * G.per, kb = r / G.nblk, nb = r - kb * G.nblk, k0 = 64 * kb, n0 = 64 * nb;
    const int lk = lane >> 4, ln4 = (lane & 15) * 4, c = lane >> 4, ns = lane & 15;
    f32x4 g[4];
#pragma unroll
    for (int q = 0; q < 4; ++q) { g[q] = (f32x4){scale, scale, scale, scale}; if (gain) g[q] = g[q] * *(const f32x4*)(gain + k0 + 16 * c + 4 * q); }
#pragma unroll
    for (int i = 0; i < 16; ++i) { LAS float* d = scr + (4 * i + lk) * 65 + ln4; d[0] = v[i].x; d[1] = v[i].y; d[2] = v[i].z; d[3] = v[i].w; }
    asm volatile("s_waitcnt lgkmcnt(0)" ::: "memory");
#pragma unroll
    for (int j = 0; j < 4; ++j) { const int n = ns + 16 * j; const LAS float* q = scr + (16 * c) * 65 + n;
        f32x4 a[4];
#pragma unroll
        for (int t = 0; t < 4; ++t) { a[t].x = q[(4 * t) * 65] * g[t].x; a[t].y = q[(4 * t + 1) * 65] * g[t].y; a[t].z = q[(4 * t + 2) * 65] * g[t].z; a[t].w = q[(4 * t + 3) * 65] * g[t].w; }
        const u32x2 lo = pack8_fp8(a[0], a[1]), hi = pack8_fp8(a[2], a[3]);
        *(u32x4*)(WT + (size_t)rm(e, n0 + n) * ldt + k0 + 16 * c) = (u32x4){lo.x, lo.y, hi.x, hi.y}; }
    asm volatile("s_waitcnt lgkmcnt(0)" ::: "memory");
}
template <bool F8 = false, class RowMap>
__device__ __forceinline__ void tr_job(const float* W, int nmat, int K, int N, const float* gain, bf16_t* WT, const RowMap rm, LAS float* scr, int gw, int ngw, int lane, int ldt = 0, int j0 = 0, int j1 = 1 << 20, float f8scale = 1.f) {
    if (ldt == 0) ldt = K;
    TrGeo G; G.nblk = N / 64; G.per = G.nblk * (K / 64); G.K = K; G.N = N;
    int total = nmat * G.per;
    { const long lim = (long)gw + (long)j1 * ngw; if (lim < total) total = (int)lim; }
    f32x4 va[16], vb[16];
    int it = gw + j0 * ngw;
    if (it >= total) return;
    tr_load(W, G, it, lane, va);
    asm volatile("" ::: "memory");
    for (;;) {
        const int it2 = it + ngw;
        tr_load(W, G, it2 < total ? it2 : it, lane, vb);
        asm volatile("" ::: "memory");
        if constexpr (F8) tr_store8(G, it, lane, va, gain, f8scale, (unsigned char*)WT, rm, scr, ldt); else tr_store(G, it, lane, va, gain, WT, rm, scr, ldt);
        asm volatile("" ::: "memory");
        if (it2 >= total) break;
        const int it3 = it2 + ngw;
        tr_load(W, G, it3 < total ? it3 : it2, lane, va);
        asm volatile("" ::: "memory");
        if constexpr (F8) tr_store8(G, it2, lane, vb, gain, f8scale, (unsigned char*)WT, rm, scr, ldt); else tr_store(G, it2, lane, vb, gain, WT, rm, scr, ldt);
        asm volatile("" ::: "memory");
        if (it3 >= total) break;
        it = it3;
    }
}
struct RmId { int off; __device__ int operator()(int, int n) const { return off + n; } };
struct RmWin { __device__ int operator()(int, int n) const { if (n < 2816) return n; const int j = n - 2816; return 2816 + (j < 32 ? 2 * j : 2 * (j - 32) + 1); } };
struct RmUq { __device__ int operator()(int, int n) const { const int h = n / 192, dd = n - h * 192; if (dd < 128) return n; const int j = dd - 128; return h * 192 + 128 + (j < 32 ? 2 * j : 2 * (j - 32) + 1); } };
struct RmGate { int up; __device__ int operator()(int e, int n) const { return e * 1024 + (n >> 7) * 256 + up * 128 + (n & 127); } };
struct RmDown { __device__ int operator()(int e, int n) const { return e * 2048 + n; } };

__device__ __forceinline__ void rms_row_load(const float* xrow, int lane, f32x4 (&v)[8]) {
#pragma unroll
    for (int j = 0; j < 8; ++j) v[j] = *(const f32x4*)(xrow + 4 * lane + 256 * j);
}
__device__ __forceinline__ void rms_row_finish(const f32x4 (&v)[8], bf16_t* orow, int lane, float* rstd_out) {
    float s = 0.f;
#pragma unroll
    for (int j = 0; j < 8; ++j) s += (v[j].x * v[j].x + v[j].y * v[j].y) + (v[j].z * v[j].z + v[j].w * v[j].w);
    const float rs = 1.0f / sqrtf(wave_sum(s) * (1.0f / DM) + EPS);
    if (rstd_out && lane == 0) *rstd_out = rs;
#pragma unroll
    for (int j = 0; j < 8; ++j) { u32x2 w; w.x = cvt_pk_bf16(v[j].x * rs, v[j].y * rs); w.y = cvt_pk_bf16(v[j].z * rs, v[j].w * rs); *(u32x2*)(orow + 4 * lane + 256 * j) = w; }
}
__device__ __forceinline__ void rms_row_bf16(const float* xrow, const float* g, bf16_t* orow, int lane, float* rstd_out = nullptr) {
    f32x4 v[8]; float s = 0.f;
#pragma unroll
    for (int j = 0; j < 8; ++j) { v[j] = *(const f32x4*)(xrow + 4 * lane + 256 * j); s += (v[j].x * v[j].x + v[j].y * v[j].y) + (v[j].z * v[j].z + v[j].w * v[j].w); }
    const float rs = 1.0f / sqrtf(wave_sum(s) * (1.0f / DM) + EPS);
    if (rstd_out && lane == 0) *rstd_out = rs;
#pragma unroll
    for (int j = 0; j < 8; ++j) { const f32x4 gg = g ? *(const f32x4*)(g + 4 * lane + 256 * j) : (f32x4){1.f, 1.f, 1.f, 1.f}; u32x2 w; w.x = cvt_pk_bf16(v[j].x * rs * gg.x, v[j].y * rs * gg.y); w.y = cvt_pk_bf16(v[j].z * rs * gg.z, v[j].w * rs * gg.w);
        *(u32x2*)(orow + 4 * lane + 256 * j) = w; }
}

constexpr int XC_PER = 32768, XC_ITEMS = 3 * XC_PER;
struct XcPtrs { const float *w0, *w1, *w2, *gain; unsigned char *gu, *wd; };
__device__ __forceinline__ void xc_load(const XcPtrs& F, int g, int lane, f32x4 (&v)[8]) {
    const int job = g >> 15, it = g & (XC_PER - 1), e = it >> 9, r = it & 511;
    const int N = job < 2 ? DE : DM, kb = job < 2 ? (r >> 4) : (r >> 6), nb = job < 2 ? (r & 15) : (r & 63);
    const float* W = job == 0 ? F.w0 : (job == 1 ? F.w1 : F.w2);
    const float* src = W + (size_t)e * DM * DE + (size_t)(64 * kb + (lane >> 3)) * N + 32 * nb + (lane & 7) * 4;
#pragma unroll
    for (int i = 0; i < 8; ++i) v[i] = *(const f32x4*)(src + (size_t)(8 * i) * N);
}
__device__ __forceinline__ void xc_store(const XcPtrs& F, int g, int lane, const f32x4 (&v)[8], LAS float* scr) {
    const int job = g >> 15, it = g & (XC_PER - 1), e = it >> 9, r = it & 511;
    const int kb = job < 2 ? (r >> 4) : (r >> 6), nb = job < 2 ? (r & 15) : (r & 63), k0 = 64 * kb, n0 = 32 * nb;
    const int ldt = job < 2 ? DM : DE;
    const float scale = job < 2 ? 256.f : 128.f;
    unsigned char* WT = job < 2 ? F.gu : F.wd;
    const int lk = lane >> 3, ln4 = (lane & 7) * 4, c = lane >> 4, ns = lane & 15;
#pragma unroll
    for (int i = 0; i < 8; ++i) { LAS float* d = scr + (8 * i + lk) * 33 + ln4; d[0] = v[i].x; d[1] = v[i].y; d[2] = v[i].z; d[3] = v[i].w; }
    f32x4 gq[4];
#pragma unroll
    for (int q = 0; q < 4; ++q) gq[q] = (f32x4){scale, scale, scale, scale};
    if (job < 2) {
#pragma unroll
        for (int q = 0; q < 4; ++q) gq[q] = gq[q] * *(const f32x4*)(F.gain + k0 + 16 * c + 4 * q);
    }
    asm volatile("s_waitcnt lgkmcnt(0)" ::: "memory");
#pragma unroll
    for (int j = 0; j < 2; ++j) { const int n = ns + 16 * j, nn = n0 + n; const LAS float* q = scr + (16 * c) * 33 + n;
        f32x4 a[4];
#pragma unroll
        for (int t = 0; t < 4; ++t) { a[t].x = q[(4 * t) * 33] * gq[t].x; a[t].y = q[(4 * t + 1) * 33] * gq[t].y; a[t].z = q[(4 * t + 2) * 33] * gq[t].z; a[t].w = q[(4 * t + 3) * 33] * gq[t].w; }
        const u32x2 lo = pack8_fp8(a[0], a[1]), hi = pack8_fp8(a[2], a[3]);
        const int row = job < 2 ? e * 1024 + (nn >> 7) * 256 + job * 128 + (nn & 127) : e * 2048 + nn;
        *(u32x4*)(WT + (size_t)row * ldt + k0 + 16 * c) = (u32x4){lo.x, lo.y, hi.x, hi.y}; }
    asm volatile("s_waitcnt lgkmcnt(0)" ::: "memory");
}
__device__ __forceinline__ void expert_convert(Frame& FR, int ja, int jb) {
    int t_ = (int)threadIdx.x; asm volatile("" : "+v"(t_));
    const int lane = t_ & 63, wave = __builtin_amdgcn_readfirstlane(t_ >> 6);
    LAS float* scr = (LAS float*)(FR.lds + wave * 16640);
    const int gw = FR.vcu * 8 + wave, ngw = FR.G * 8;
    const XcPtrs F{FR.in[26], FR.in[27], FR.in[28], FR.in[21], FR.ws + WS_WGU, FR.ws + WS_WD};
    int total = XC_ITEMS;
    { const long lim = (long)gw + (long)jb * ngw; if (lim < total) total = (int)lim; }
    int g0 = gw + ja * ngw;
    if (g0 >= total) return;
    f32x4 v0[8], v1[8], v2[8], v3[8], v4[8];
#define XC_CL(x) ((x) < total ? (x) : g0)
#define XC_F asm volatile("" ::: "memory")
    xc_load(F, g0, lane, v0); XC_F; xc_load(F, XC_CL(g0 + ngw), lane, v1); XC_F; xc_load(F, XC_CL(g0 + 2 * ngw), lane, v2); XC_F; xc_load(F, XC_CL(g0 + 3 * ngw), lane, v3); XC_F;
    for (;;) {
        xc_load(F, XC_CL(g0 + 4 * ngw), lane, v4); XC_F; xc_store(F, g0, lane, v0, scr); XC_F; if (g0 + ngw >= total) break;
        xc_load(F, XC_CL(g0 + 5 * ngw), lane, v0); XC_F; xc_store(F, g0 + ngw, lane, v1, scr); XC_F; if (g0 + 2 * ngw >= total) break;
        xc_load(F, XC_CL(g0 + 6 * ngw), lane, v1); XC_F; xc_store(F, g0 + 2 * ngw, lane, v2, scr); XC_F; if (g0 + 3 * ngw >= total) break;
        xc_load(F, XC_CL(g0 + 7 * ngw), lane, v2); XC_F; xc_store(F, g0 + 3 * ngw, lane, v3, scr); XC_F; if (g0 + 4 * ngw >= total) break;
        xc_load(F, XC_CL(g0 + 8 * ngw), lane, v3); XC_F; xc_store(F, g0 + 4 * ngw, lane, v4, scr); XC_F; if (g0 + 5 * ngw >= total) break;
        g0 += 5 * ngw;
    }
#undef XC_CL
#undef XC_F
}
__device__ __forceinline__ void p0_prologue(Frame& F) {
    LAS float* scr = (LAS float*)(F.lds + __builtin_amdgcn_readfirstlane((int)threadIdx.x >> 6) * 16640);
    const int gw = F.vcu * 8 + __builtin_amdgcn_readfirstlane((int)threadIdx.x >> 6), ngw = F.G * 8, lane = ((int)threadIdx.x & 63);
    const int gt = gw * 64 + lane, ngt = ngw * 64;
#define ROT(r) ((gw + ngw - ((r) % ngw)) % ngw)
    tr_job(F.in[3], 1, DM, INW, F.in[2], WSP(bf16_t, WS_WIN), RmWin{}, scr, ROT(0), ngw, lane);
    tr_job(F.in[9], 1, QL, NQ, F.in[8], WSP(bf16_t, WS_WUQ), RmUq{}, scr, ROT(1440), ngw, lane);
    tr_job(F.in[11], 1, KVL, NKV, F.in[10], WSP(bf16_t, WS_WUKV), RmId{0}, scr, ROT(1632), ngw, lane);
    tr_job(F.in[14], 1, GW, DM, F.in[12], WSP(bf16_t, WS_WOA), RmId{0}, scr, ROT(1760), ngw, lane, DM);
    tr_job(F.in[14] + (size_t)GW * DM, 1, GW, DM, F.in[13], WSP(bf16_t, WS_WOA) + GW, RmId{0}, scr, ROT(2272), ngw, lane, DM);
    tr_job(F.in[17], 1, DM, 512, F.in[15], WSP(bf16_t, WS_WMQ), RmId{0}, scr, ROT(2784), ngw, lane);
    tr_job(F.in[18], 1, DM, 512, nullptr, WSP(bf16_t, WS_WMKV), RmId{0}, scr, ROT(3040), ngw, lane);
    tr_job(F.in[19], 1, DM, 512, nullptr, WSP(bf16_t, WS_WMKV), RmId{512}, scr, ROT(3296), ngw, lane);
    tr_job<true>(F.in[20], 1, 512, DM, nullptr, WSP(bf16_t, WS_WMO), RmId{0}, scr, ROT(3552), ngw, lane, 0, 0, 1 << 20, 128.f);
    tr_job(F.in[24], 1, DM, 64, F.in[21], WSP(bf16_t, WS_WR), RmId{8}, scr, ROT(3808), ngw, lane);
#undef ROT
    for (int i = gt; i < DM * 8; i += ngt) { const int k = i >> 3, n = i & 7; WSP(bf16_t, WS_WR)[(size_t)n * DM + k] = (bf16_t)(cvt_pk_bf16(F.in[22][i] * F.in[21][k], 0.f) & 0xffffu); }
    for (int i = gt; i < (INWP - INW) * DM / 8; i += ngt) ((u32x4*)(WSP(bf16_t, WS_WIN) + (size_t)INW * DM))[i] = (u32x4){0u, 0u, 0u, 0u};
    for (int i = gt; i < (256 - 72) * DM / 8; i += ngt) ((u32x4*)(WSP(bf16_t, WS_WR) + (size_t)72 * DM))[i] = (u32x4){0u, 0u, 0u, 0u};
    for (int i = gt; i < DM / 8; i += ngt) ((u32x4*)(WSP(bf16_t, WS_HB) + (size_t)T * DM))[i] = (u32x4){0u, 0u, 0u, 0u};
    for (int i = gt; i < DM / 16; i += ngt) ((u32x4*)(WSP(unsigned char, WS_X8) + (size_t)T * DM))[i] = (u32x4){0u, 0u, 0u, 0u};
    for (int i = gt; i < 8 * 128 * 128; i += ngt) { const int sI = i & 127, tI = (i >> 7) & 127; WSP(bf16_t, WS_WSPB)[i] = (sI <= tI) ? (bf16_t)(cvt_pk_bf16(F.in[6][i], 0.f) & 0xffffu) : (bf16_t)0; }
    for (int i = gt; i < 512 * DM / 8; i += ngt) { const f32x4 a = *(const f32x4*)(F.in[20] + (size_t)i * 8), b = *(const f32x4*)(F.in[20] + (size_t)i * 8 + 4); ((u32x4*)WSP(bf16_t, WS_WMOB))[i] = pack8(a, b); }
    for (int i = gt; i < 256; i += ngt) WSP(float, WS_RB)[i] = i < 8 ? F.in[23][i] : (i < 72 ? F.in[25][i - 8] : 0.f);
    for (int i = gt; i < SEQ * 32; i += ngt) { const int pos = i >> 5, k = i & 31; const float invf = (float)pow(10000.0, -(double)(2 * k) / 64.0); const float ang = (float)pos * invf;
        WSP(float, WS_COS)[i] = (float)cos((double)ang); WSP(float, WS_SIN)[i] = (float)sin((double)ang); }
    {
        f32x4 va[8], vb[8];
        int r = gw;
        if (r < T) {
            rms_row_load(F.in[0] + (size_t)r * DM, lane, va); asm volatile("" ::: "memory");
            for (;;) {
                const int r1 = r + ngw, r2 = r1 + ngw;
                rms_row_load(F.in[0] + (size_t)(r1 < T ? r1 : r) * DM, lane, vb); asm volatile("" ::: "memory");
                rms_row_finish(va, WSP(bf16_t, WS_HB) + (size_t)r * DM, lane, WSP(float, WS_RSTDX) + r); asm volatile("" ::: "memory");
                if (r1 >= T) break;
                rms_row_load(F.in[0] + (size_t)(r2 < T ? r2 : r1) * DM, lane, va); asm volatile("" ::: "memory");
                rms_row_finish(vb, WSP(bf16_t, WS_HB) + (size_t)r1 * DM, lane, WSP(float, WS_RSTDX) + r1); asm volatile("" ::: "memory");
                if (r2 >= T) break;
                r = r2;
            }
        }
    }
    for (int r = gw; r < NBATCH * MEMLEN; r += ngw) rms_row_bf16(F.in[1] + (size_t)r * DM, F.in[16], WSP(bf16_t, WS_MEMN) + (size_t)r * DM, lane);
}

__device__ __forceinline__ void gmlp_phase(Frame& F) {
    const bf16_t* UV = WSP(bf16_t, WS_UV); bf16_t* AB = WSP(bf16_t, WS_AB); const bf16_t* WSPB = WSP(bf16_t, WS_WSPB);
    const stat_t* vsum = STAT(F, ST_VSUM); const stat_t* vsq = STAT(F, ST_VSQ); stat_t* ssq_a = STAT(F, ST_A);
    const float *g_v = F.in[4], *b_v = F.in[5], *bsp = F.in[7];
    int tid_ = ((int)threadIdx.x); asm volatile("" : "+v"(tid_));
    const int tid = tid_, wid = tid >> 6, lane = tid & 63, r32 = lane & 31, hi = lane >> 5, gsel = wid >> 2, w4 = wid & 3;
    char* lds = (char*)F.lds;
    float* stage = (float*)(lds + 65536 + wid * 8192);
    const int vb0 = (int)(uintptr_t)lds + att::v_rd_base(lane);
    const int sr = tid >> 4, c8 = (tid & 15) * 8;
    const bool deal3 = (F.G == 256);
    const int bxg = (int)blockIdx.x, nmine = deal3 ? (bxg < 128 ? 1 : 3) : (512 - F.vcu + F.G - 1) / F.G;
    for (int ui = 0; ui < nmine; ++ui) {
        const int unit = deal3 ? (bxg < 128 ? bxg : 128 + 3 * (bxg - 128) + ui) : F.vcu + ui * F.G;
        const int t0 = (unit >> 2) * 128, gp = unit & 3;
        const int g = gp * 2 + gsel, rr = lane >> 1, cb = (lane & 1) * 32, t = 32 * w4 + rr, gr = t0 + t;
        u32x4 wv[2][4]; stat_t rs_[4], rq_[4];
#pragma unroll
        for (int k = 0; k < 4; ++k) { rs_[k] = vsum[t0 + sr + 32 * k]; rq_[k] = vsq[t0 + sr + 32 * k]; }
#pragma unroll
        for (int gl = 0; gl < 2; ++gl)
#pragma unroll
            for (int k = 0; k < 4; ++k) wv[gl][k] = *(const u32x4*)(UV + (size_t)(t0 + sr + 32 * k) * DM + GW + (gp * 2 + gl) * 128 + c8);
        asm volatile("" ::: "memory");
        u32x4 uu[2][4]; bf16x8 pa[2][4];
#pragma unroll
        for (int half = 0; half < 2; ++half)
#pragma unroll
            for (int i = 0; i < 4; ++i) uu[half][i] = *(const u32x4*)(UV + (size_t)gr * DM + g * 128 + half * 64 + cb + 8 * i);
#pragma unroll
        for (int st = 0; st < 2; ++st) { const bf16_t* wrow = WSPB + ((size_t)(g * 128 + 32 * w4 + r32) * 128 + 64 * st + 8 * hi);
#pragma unroll
            for (int j = 0; j < 4; ++j) pa[st][j] = *(const bf16x8*)(wrow + 16 * j); }
        const float bias = bsp[g * 128 + t];
        asm volatile("" ::: "memory");
        {
            float mean[4], rstd[4];
#pragma unroll
            for (int k = 0; k < 4; ++k) { mean[k] = (float)((double)(long long)rs_[k] * 2.3283064365386963e-10) * (1.0f / GW); const float var = (float)((double)(long long)rq_[k] * 2.3283064365386963e-10) * (1.0f / GW) - mean[k] * mean[k]; rstd[k] = 1.0f / sqrtf(var + 1e-5f); }
#pragma unroll
            for (int gl = 0; gl < 2; ++gl) { const int gg = gp * 2 + gl;
                const f32x4 ga = *(const f32x4*)(g_v + gg * 128 + c8), gb = *(const f32x4*)(g_v + gg * 128 + c8 + 4), ba = *(const f32x4*)(b_v + gg * 128 + c8), bb = *(const f32x4*)(b_v + gg * 128 + c8 + 4);
#pragma unroll
                for (int k = 0; k < 4; ++k) { const int sl = sr + 32 * (k & 1), st = k >> 1;
                    const u32x4 w = wv[gl][k];
                    f32x4 x0 = {bf_lo(w.x), bf_hi(w.x), bf_lo(w.y), bf_hi(w.y)}, x1 = {bf_lo(w.z), bf_hi(w.z), bf_lo(w.w), bf_hi(w.w)};
                    x0 = (x0 - mean[k]) * rstd[k] * ga + ba; x1 = (x1 - mean[k]) * rstd[k] * gb + bb;
                    *(u32x4*)(lds + (gl * 2 + st) * 16384 + att::v_st(sl, c8)) = pack8(x0, x1); } }
        }
        __syncthreads();
        f32x16 o[4] = {};
#pragma unroll
        for (int st = 0; st < 2; ++st) {
            if (st == 1 && w4 < 2) continue;
            att::pv_d0(o, vb0 + (gsel * 2 + st) * 16384, pa[st][0], pa[st][1], pa[st][2], pa[st][3]);
        }
#pragma unroll
        for (int half = 0; half < 2; ++half) {
#pragma unroll
            for (int d = 0; d < 2; ++d)
#pragma unroll
                for (int r = 0; r < 16; ++r) stage[((r & 3) + 8 * (r >> 2) + 4 * hi) * 64 + d * 32 + r32] = o[2 * half + d][r];
            asm volatile("s_waitcnt lgkmcnt(0)" ::: "memory");
            float s2 = 0.f;
            const size_t goff = (size_t)gr * DM + g * 128 + half * 64 + cb;
#pragma unroll
            for (int i = 0; i < 4; ++i) {
                const f32x4 sa = *(const f32x4*)(stage + rr * 64 + cb + 8 * i), sb = *(const f32x4*)(stage + rr * 64 + cb + 8 * i + 4);
                const u32x4 w = uu[half][i];
                const f32x4 u0 = {bf_lo(w.x), bf_hi(w.x), bf_lo(w.y), bf_hi(w.y)}, u1 = {bf_lo(w.z), bf_hi(w.z), bf_lo(w.w), bf_hi(w.w)};
                const f32x4 a0 = u0 * (sa + bias), a1 = u1 * (sb + bias);
                *(u32x4*)(AB + goff + 8 * i) = pack8(a0, a1);
                s2 += (a0.x * a0.x + a0.y * a0.y) + (a0.z * a0.z + a0.w * a0.w) + (a1.x * a1.x + a1.y * a1.y) + (a1.z * a1.z + a1.w * a1.w);
            }
            s2 += __shfl_xor(s2, 1);
            if ((lane & 1) == 0) stat_add(ssq_a + gr, s2);
            asm volatile("s_waitcnt lgkmcnt(0)" ::: "memory");
        }
        __syncthreads();
    }
}

__device__ __forceinline__ void moe_tiles(Frame& F) {
    LAS int* ts = (LAS int*)(F.lds + TS_OFF); const int* cnt = (const int*)(F.ctl + CW_CNT);
    if (((int)threadIdx.x) < 64) {
        const int lane = ((int)threadIdx.x), c = cnt[lane], nt = (c + 255) >> 8, hf = (nt > 0 && (c - (nt - 1) * 256) <= 128) ? 1 : 0;
        int a = nt, f = nt - hf, h = hf;
#pragma unroll
        for (int o = 1; o < 64; o <<= 1) { const int ua = __shfl_up(a, o), uf = __shfl_up(f, o), uh = __shfl_up(h, o); if (lane >= o) { a += ua; f += uf; h += uh; } }
        ts[lane] = a - nt; ts[80 + lane] = f - (nt - hf); ts[160 + lane] = h - hf;
        if (lane == 63) { ts[NEXP] = a; ts[80 + NEXP] = f; ts[160 + NEXP] = h; }
    }
    __syncthreads();
}

__device__ __forceinline__ void ld_row(const bf16_t* p, int lane, u32x4 (&v)[4]) {
#pragma unroll
    for (int j = 0; j < 4; ++j) v[j] = *(const u32x4*)(p + 8 * (lane + 64 * j));
}
__device__ __forceinline__ void ld_row8(const unsigned char* p, int lane, u32x2 (&v)[4]) {
#pragma unroll
    for (int j = 0; j < 4; ++j) v[j] = *(const u32x2*)(p + 8 * (lane + 64 * j));
}
__device__ __forceinline__ float mix_row8(const u32x4 (&x)[4], const u32x2 (&a)[4], const u32x2 (&b)[4], float w0, float w1, f32x4 (&v)[8]) {
    float s = 0.f;
#pragma unroll
    for (int j = 0; j < 4; ++j) {
        const f32x2 a0 = __builtin_amdgcn_cvt_pk_f32_fp8((int)a[j].x, false), a1 = __builtin_amdgcn_cvt_pk_f32_fp8((int)a[j].x, true), a2 = __builtin_amdgcn_cvt_pk_f32_fp8((int)a[j].y, false), a3 = __builtin_amdgcn_cvt_pk_f32_fp8((int)a[j].y, true);
        const f32x2 b0 = __builtin_amdgcn_cvt_pk_f32_fp8((int)b[j].x, false), b1 = __builtin_amdgcn_cvt_pk_f32_fp8((int)b[j].x, true), b2 = __builtin_amdgcn_cvt_pk_f32_fp8((int)b[j].y, false), b3 = __builtin_amdgcn_cvt_pk_f32_fp8((int)b[j].y, true);
        f32x4 lo, hi;
        lo.x = bf_lo(x[j].x) + (w0 * a0.x + w1 * b0.x); lo.y = bf_hi(x[j].x) + (w0 * a0.y + w1 * b0.y);
        lo.z = bf_lo(x[j].y) + (w0 * a1.x + w1 * b1.x); lo.w = bf_hi(x[j].y) + (w0 * a1.y + w1 * b1.y);
        hi.x = bf_lo(x[j].z) + (w0 * a2.x + w1 * b2.x); hi.y = bf_hi(x[j].z) + (w0 * a2.y + w1 * b2.y);
        hi.z = bf_lo(x[j].w) + (w0 * a3.x + w1 * b3.x); hi.w = bf_hi(x[j].w) + (w0 * a3.y + w1 * b3.y);
        v[2 * j] = lo; v[2 * j + 1] = hi;
        s += ((lo.x * lo.x + lo.y * lo.y) + (lo.z * lo.z + lo.w * lo.w)) + ((hi.x * hi.x + hi.y * hi.y) + (hi.z * hi.z + hi.w * hi.w));
    }
    return s;
}
__device__ __forceinline__ float mix_row(const u32x4 (&x)[4], const u32x4 (&a)[4], const u32x4 (&b)[4], float w0, float w1, f32x4 (&v)[8]) {
    float s = 0.f;
#pragma unroll
    for (int j = 0; j < 4; ++j) {
        f32x4 lo, hi;
        lo.x = bf_lo(x[j].x) + (w0 * bf_lo(a[j].x) + w1 * bf_lo(b[j].x)); lo.y = bf_hi(x[j].x) + (w0 * bf_hi(a[j].x) + w1 * bf_hi(b[j].x));
        lo.z = bf_lo(x[j].y) + (w0 * bf_lo(a[j].y) + w1 * bf_lo(b[j].y)); lo.w = bf_hi(x[j].y) + (w0 * bf_hi(a[j].y) + w1 * bf_hi(b[j].y));
        hi.x = bf_lo(x[j].z) + (w0 * bf_lo(a[j].z) + w1 * bf_lo(b[j].z)); hi.y = bf_hi(x[j].z) + (w0 * bf_hi(a[j].z) + w1 * bf_hi(b[j].z));
        hi.z = bf_lo(x[j].w) + (w0 * bf_lo(a[j].w) + w1 * bf_lo(b[j].w)); hi.w = bf_hi(x[j].w) + (w0 * bf_hi(a[j].w) + w1 * bf_hi(b[j].w));
        v[2 * j] = lo; v[2 * j + 1] = hi;
        s += ((lo.x * lo.x + lo.y * lo.y) + (lo.z * lo.z + lo.w * lo.w)) + ((hi.x * hi.x + hi.y * hi.y) + (hi.z * hi.z + hi.w * hi.w));
    }
    return s;
}
__device__ __forceinline__ void st_row(float* o, const float* gf, int lane, const f32x4 (&v)[8], float rs) {
#pragma unroll
    for (int j = 0; j < 4; ++j) { const int c = 8 * (lane + 64 * j); const f32x4 g0 = *(const f32x4*)(gf + c), g1 = *(const f32x4*)(gf + c + 4);
        *(f32x4*)(o + c) = v[2 * j] * rs * g0; *(f32x4*)(o + c + 4) = v[2 * j + 1] * rs * g1; }
}
__device__ __forceinline__ void final_phase(Frame& F) {
    const unsigned char* YS = WSP(unsigned char, WS_YS); const bf16_t* XB = WSP(bf16_t, WS_HB); const float* gf = F.in[29];
    const int* toke = WSP(int, WS_TOKE); const float* tokw = WSP(float, WS_TOKW); const LAS int* ts = (const LAS int*)(F.lds + TS_OFF);
    const int gw = F.vcu * 8 + __builtin_amdgcn_readfirstlane((int)threadIdx.x >> 6), ngw = F.G * 8, lane = ((int)threadIdx.x & 63);
    for (int r = gw; r < T; r += 2 * ngw) {
        const int r2 = (r + ngw < T) ? r + ngw : r;
        const int ea = toke[2 * r], eb = toke[2 * r + 1], ec = toke[2 * r2], ed = toke[2 * r2 + 1];
        const size_t sa = (size_t)(ts[ea >> 16] * 256 + (ea & 0xffff)), sb = (size_t)(ts[eb >> 16] * 256 + (eb & 0xffff));
        const size_t sc = (size_t)(ts[ec >> 16] * 256 + (ec & 0xffff)), sd = (size_t)(ts[ed >> 16] * 256 + (ed & 0xffff));
        u32x4 x0[4], x1[4]; u32x2 a0[4], b0[4], a1[4], b1[4];
        ld_row(XB + (size_t)r * DM, lane, x0); ld_row8(YS + sa * DM, lane, a0); ld_row8(YS + sb * DM, lane, b0);
        ld_row(XB + (size_t)r2 * DM, lane, x1); ld_row8(YS + sc * DM, lane, a1); ld_row8(YS + sd * DM, lane, b1);
        f32x4 v0[8], v1[8];
        const float s0 = mix_row8(x0, a0, b0, tokw[2 * r], tokw[2 * r + 1], v0);
        const float s1 = mix_row8(x1, a1, b1, tokw[2 * r2], tokw[2 * r2 + 1], v1);
        const float rs0 = 1.0f / sqrtf(wave_sum(s0) * (1.0f / DM) + EPS), rs1 = 1.0f / sqrtf(wave_sum(s1) * (1.0f / DM) + EPS);
        st_row(F.out + (size_t)r * DM, gf, lane, v0, rs0);
        st_row(F.out + (size_t)r2 * DM, gf, lane, v1, rs1);
    }
}

constexpr int NPH = 13;
struct Args { const float* in[30]; float* out; unsigned char* ws; int ph_lo, ph_hi; };
__global__ void __launch_bounds__(512, 2) fwd(Args args) {
    extern __shared__ __attribute__((aligned(16))) unsigned char lds_raw[];
    Frame F;
    F.lds = (LAS unsigned char*)lds_raw;
    F.G = gridDim.x; { const int bx = blockIdx.x; F.vcu = (F.G % 8 == 0) ? (bx % 8) * (F.G / 8) + bx / 8 : bx; }
#pragma unroll
    for (int i = 0; i < 30; ++i) F.in[i] = args.in[i];
    F.out = args.out; F.ws = args.ws; F.ctl = (unsigned*)(args.ws + WS_CTL);
    volatile LAS unsigned* MISC = (volatile LAS unsigned*)(F.lds + MISC_OFF);
    if (((int)threadIdx.x) < 32) MISC[((int)threadIdx.x)] = 0u;
    __syncthreads();
    const int lo = args.ph_lo, hi = args.ph_hi;
    const bool multi = (hi - lo) > 1;
    XcdBarrier bar; bar.bar = F.ctl + CW_BAR; bar.x = 0; bar.st = nullptr;
    if (multi) bar = xcd_barrier_post(F.ctl + CW_BAR, MISC + 8);
#ifndef ONLYP
#define ONLYP -1
#endif
#define IN(k) ((ONLYP < 0 || ONLYP == (k)) && lo <= (k) && (k) < hi)
#define SEAM(k) do { if (IN(k) && IN((k) + 1)) xcd_barrier(bar); } while (0)
    float* const out = F.out;
    const int bx = (int)blockIdx.x;

    if (IN(0)) { p0_prologue(F); }
    SEAM(0);
    if (IN(1)) {
        pg8::Gemm g{WSP(bf16_t, WS_HB), WSP(bf16_t, WS_WIN), DM, DM, DM}; pg8::StaticOrder S0; S0.init(T, INWP, F.G, bx);
        EpiZ E{WSP(bf16_t, WS_UV), WSP(bf16_t, WS_CQ), WSP(bf16_t, WS_CKV), WSP(bf16_t, WS_KR), STAT(F, ST_VSUM), STAT(F, ST_VSQ), STAT(F, ST_Q), STAT(F, ST_KV), WSP(float, WS_COS), WSP(float, WS_SIN)};
        const int kcut = (bx & 7) >> 1;
        { pg8::SubOrder S{S0, 0, kcut}; pg8::gemm_phase(F.lds, g, S, E); }
        __syncthreads(); expert_convert(F, 0, F.G == 256 ? 18 : (1 << 20)); __syncthreads();
        { pg8::SubOrder S{S0, kcut, 1 << 20}; pg8::gemm_phase(F.lds, g, S, E); }
    }
    SEAM(1);
    if (IN(2)) {
        { pg8::Gemm g{WSP(bf16_t, WS_CQ), WSP(bf16_t, WS_WUQ), QL, QL, QL}; pg8::StaticOrder S; S.init(T, NQ, F.G, bx);
          EpiQ E{WSP(bf16_t, WS_Q), STAT(F, ST_Q), WSP(float, WS_COS), WSP(float, WS_SIN)};
          pg8::gemm_phase(F.lds, g, S, E); }
        { pg8::Gemm g{WSP(bf16_t, WS_CKV), WSP(bf16_t, WS_WUKV), KVL, KVL, KVL}; pg8::StaticOrder S; S.init(T, NKV, F.G, (bx + 128) % F.G);
          EpiScaleBf16 E{WSP(bf16_t, WS_KV), NKV, STAT(F, ST_KV), 1.0f / KVL};
          pg8::gemm_phase(F.lds, g, S, E); }
        __syncthreads();
        gmlp_phase(F);
    }
    SEAM(2);
    if (IN(3)) {
        const bf16_t* Q = WSP(bf16_t, WS_Q); const bf16_t* KV = WSP(bf16_t, WS_KV); const bf16_t* KR = WSP(bf16_t, WS_KR); bf16_t* MB = WSP(bf16_t, WS_AB);
        const int cgrp = bx & 1;
        if (F.G == 256 && cgrp == 0) { expert_convert(F, 18, 36); __syncthreads(); }
        for (int v = F.vcu; v < 256; v += F.G) {
            const int bh = v >> 2, b = bh >> 3, h = bh & 7, s = v & 3;
#pragma unroll 1
            for (int half = 0; half < 2; ++half) {
                const int qb = half ? 7 - s : s; const size_t r0 = (size_t)b * SEQ + qb * 256, k0 = (size_t)b * SEQ;
                att::attn_unit<64, true, NQ, NKV, DM>(Q + r0 * NQ + h * 192, KV + k0 * NKV + h * 256, KV + k0 * NKV + h * 256 + 128, KR + k0 * ROPE,
                                                      MB + r0 * DM + GW + h * 128, 4 * (qb + 1), STAT(F, ST_M) + r0, (char*)lds_raw);
            }
        }
        if (F.G == 256 && cgrp == 1) { __syncthreads(); expert_convert(F, 18, 36); }
    }
    SEAM(3);
    if (IN(4)) {
        pg8::Gemm g{WSP(bf16_t, WS_AB), WSP(bf16_t, WS_WOA), DM, DM, DM}; pg8::StaticOrder S0; S0.init(T, DM, F.G, bx);
        EpiMix E{WSP(float, WS_RSTDX), STAT(F, ST_A), STAT(F, ST_M), WSP(bf16_t, WS_HB), STAT(F, ST_X1)};
        const int kcut4 = (bx & 7) % 3;
        { pg8::SubOrder S{S0, 0, kcut4}; pg8::gemm_phase(F.lds, g, S, E); }
        if (F.G == 256) { __syncthreads(); expert_convert(F, 36, 1 << 20); __syncthreads(); }
        { pg8::SubOrder S{S0, kcut4, 1 << 20}; pg8::gemm_phase(F.lds, g, S, E); }
    }
    SEAM(4);
    if (IN(5)) {
        { pg8::Gemm g{WSP(bf16_t, WS_HB), WSP(bf16_t, WS_WMQ), DM, DM, DM}; pg8::StaticOrder S; S.init(T, 512, F.G, bx);
          EpiScaleBf16 E{WSP(bf16_t, WS_XQ), 512, STAT(F, ST_X1), 1.0f / DM};
          pg8::gemm_phase(F.lds, g, S, E); }
        { pg8::Gemm g{WSP(bf16_t, WS_MEMN), WSP(bf16_t, WS_WMKV), DM, DM, DM}; pg8::StaticOrder S; S.init(NBATCH * MEMLEN, 1024, F.G, (bx + 128) % F.G);
          EpiScaleBf16 E{WSP(bf16_t, WS_MKV), 1024, nullptr, 0.f};
          pg8::gemm_phase(F.lds, g, S, E); }
        { pg8::Gemm g{WSP(bf16_t, WS_HB), WSP(bf16_t, WS_WR), DM, DM, DM}; pg8::StaticOrder S; S.init(T, 256, F.G, (bx + 96) % F.G);
          EpiLog1 E{WSP(float, WS_LOG1)};
          pg8::gemm_phase(F.lds, g, S, E); }
        { pg8::Gemm g{WSP(bf16_t, WS_WR), WSP(bf16_t, WS_WMOB), DM, DM, DM}; pg8::StaticOrder S; S.init(256, 512, F.G, (bx + 32) % F.G);
          EpiScaleF8 E{WSP(unsigned char, WS_W2T), 512, 128.f};
          pg8::gemm_phase(F.lds, g, S, E); }
    }
    SEAM(5);
    if (IN(6)) {
        const bf16_t* XQ = WSP(bf16_t, WS_XQ); const bf16_t* MKV = WSP(bf16_t, WS_MKV); unsigned char* XO = WSP(unsigned char, WS_XO);
        for (int v = F.vcu; v < 256; v += F.G) {
            const int bh = v >> 3, b = bh >> 2, h = bh & 3, qb = v & 7; const size_t r0 = (size_t)b * SEQ + qb * 256, k0 = (size_t)b * MEMLEN;
            att::attn_unit<0, false, 512, 1024, 512, true>(XQ + r0 * 512 + h * 128, MKV + k0 * 1024 + h * 128, MKV + k0 * 1024 + 512 + h * 128, nullptr,
                                                     (bf16_t*)(XO + r0 * 512 + h * 128), 4, nullptr, (char*)lds_raw);
        }
    }
    SEAM(6);
    if (IN(7)) {
        pg8::Gemm g{WSP(bf16_t, WS_XO), WSP(bf16_t, WS_WMO), 256, 256, 256}; pg8::StaticOrder S; S.init(T, DM, F.G, bx);
        EpiResidB E{WSP(bf16_t, WS_HB), STAT(F, ST_X2)};
        pg8::gemm_phase(F.lds, g, S, E);
    }
    SEAM(7);
    if (IN(8)) {
        if (bx < 64 || F.G != 256) {
            pg8::Gemm g{WSP(bf16_t, WS_XO), WSP(bf16_t, WS_W2T), 256, 256, 256}; pg8::StaticOrder S; S.init(T, 256, F.G, bx);
            EpiRoute E{WSP(float, WS_LOG1), STAT(F, ST_X2), WSP(float, WS_RB), WSP(float, WS_TOKW), WSP(int, WS_ROWTOK), WSP(int, WS_TOKE), (int*)(F.ctl + CW_CNT)};
            pg8::gemm_phase(F.lds, g, S, E);
        }
        {
            const int nw = (F.G == 256) ? 192 * 8 : F.G * 8, w0 = (F.G == 256) ? (bx - 64) * 8 + __builtin_amdgcn_readfirstlane((int)threadIdx.x >> 6) : bx * 8 + __builtin_amdgcn_readfirstlane((int)threadIdx.x >> 6);
            if (F.G != 256 || bx >= 64) {
                const bf16_t* XBp = WSP(bf16_t, WS_HB); unsigned char* X8p = WSP(unsigned char, WS_X8);
                const int lane = ((int)threadIdx.x & 63);
                auto ld = [&](int r, u32x4 (&v)[4]) {
#pragma unroll
                    for (int j = 0; j < 4; ++j) v[j] = *(const u32x4*)(XBp + (size_t)r * DM + 8 * (lane + 64 * j)); };
                auto st = [&](int r, const u32x4 (&v)[4]) {
#pragma unroll
                    for (int j = 0; j < 4; ++j) { const u32x4 w = v[j];
                        const f32x4 a = {bf_lo(w.x), bf_hi(w.x), bf_lo(w.y), bf_hi(w.y)}, b = {bf_lo(w.z), bf_hi(w.z), bf_lo(w.w), bf_hi(w.w)};
                        *(u32x2*)(X8p + (size_t)r * DM + 8 * (lane + 64 * j)) = pack8_fp8(a, b); } };
                u32x4 va[4], vb[4];
                int r = w0;
                if (r < T) {
                    ld(r, va); asm volatile("" ::: "memory");
                    for (;;) {
                        const int r1 = r + nw, r2 = r1 + nw;
                        ld(r1 < T ? r1 : r, vb); asm volatile("" ::: "memory");
                        st(r, va); asm volatile("" ::: "memory");
                        if (r1 >= T) break;
                        ld(r2 < T ? r2 : r1, va); asm volatile("" ::: "memory");
                        st(r1, vb); asm volatile("" ::: "memory");
                        if (r2 >= T) break;
                        r = r2;
                    }
                }
            }
        }
    }
    SEAM(8);
    if (IN(9) && !IN(8)) { }
    if (IN(9) && !IN(10)) { }
    if (IN(10)) {
        moe_tiles(F);
        MoeOrder S{(const LAS int*)(F.lds + TS_OFF), (const int*)(F.ctl + CW_CNT), WSP(int, WS_ROWTOK), 4, F.G, F.vcu, true, true};
        pg8::Gemm g{WSP(bf16_t, WS_X8), WSP(bf16_t, WS_WGU), DM / 2, DM / 2, DM / 2};
        EpiGU E{WSP(unsigned char, WS_H), STAT(F, ST_X2), (const int*)(F.ctl + CW_CNT), WSP(int, WS_ROWTOK)};
        pg8::gemm_phase(F.lds, g, S, E);
    }
    SEAM(10);
    if (IN(11)) {
        moe_tiles(F);
        MoeOrder S{(const LAS int*)(F.lds + TS_OFF), (const int*)(F.ctl + CW_CNT), WSP(int, WS_ROWTOK), 8, F.G, F.vcu, false, false};
        pg8::Gemm g{WSP(bf16_t, WS_H), WSP(bf16_t, WS_WD), DE / 2, DE / 2, DE / 2};
        EpiDown E{WSP(unsigned char, WS_YS)};
        pg8::gemm_phase(F.lds, g, S, E);
    }
    SEAM(11);
    if (IN(12)) { moe_tiles(F); final_phase(F); }
#undef IN
#undef SEAM
}

#ifndef MK_PER_PHASE
#define MK_PER_PHASE 0
#endif
extern "C" void kernel_launch(void* const* d_in, const int* in_sizes, int n_in, void* d_out, int out_size, void* d_ws, size_t ws_size, hipStream_t stream) {
    static int grid = 0;
    if (grid == 0) {
        if (n_in != 30 || out_size != T * DM || ws_size < WS_END) { fprintf(stderr, "kernel_launch: unexpected shapes / workspace (%d inputs, out %d, ws %zu, need %zu)\n", n_in, out_size, ws_size, (size_t)WS_END); grid = -1; return; }
        int dev = 0, cus = 0, per_cu = 0;
        if (hipGetDevice(&dev) != hipSuccess || hipDeviceGetAttribute(&cus, hipDeviceAttributeMultiprocessorCount, dev) != hipSuccess) { grid = -1; return; }
        if (hipFuncSetAttribute((const void*)fwd, hipFuncAttributeMaxDynamicSharedMemorySize, LDS_BYTES) != hipSuccess) { fprintf(stderr, "kernel_launch: hipFuncSetAttribute failed\n"); grid = -1; return; }
        if (hipOccupancyMaxActiveBlocksPerMultiprocessor(&per_cu, (const void*)fwd, 512, LDS_BYTES) != hipSuccess || per_cu < 1) fprintf(stderr, "kernel_launch: occupancy query says %d\n", per_cu);
        (void)hipGetLastError();
        grid = cus;
    }
    if (grid < 0) return;
    if (hipMemsetAsync((char*)d_ws + WS_CTL, 0, CTL_ZERO_BYTES, stream) != hipSuccess) return;
    Args a{};
    for (int i = 0; i < 30; ++i) a.in[i] = (const float*)d_in[i];
    a.out = (float*)d_out; a.ws = (unsigned char*)d_ws;
#if MK_PER_PHASE
    for (int p = 0; p < NPH; ++p) { a.ph_lo = p; a.ph_hi = p + 1; hipLaunchKernelGGL(fwd, dim3(grid), dim3(512), LDS_BYTES, stream, a); }
#else
    a.ph_lo = 0; a.ph_hi = NPH; hipLaunchKernelGGL(fwd, dim3(grid), dim3(512), LDS_BYTES, stream, a);
#endif
}
```

```cpp
#include <hip/hip_runtime.h>
#include <cstdio>
#include <cstdint>

#define LAS __attribute__((address_space(3)))
#define GAS __attribute__((address_space(1)))
typedef unsigned short bf16_t;
typedef short bf16x8 __attribute__((ext_vector_type(8)));
typedef short s16x4 __attribute__((ext_vector_type(4)));
typedef float f32x2 __attribute__((ext_vector_type(2)));
typedef float f32x4 __attribute__((ext_vector_type(4)));
typedef float f32x16 __attribute__((ext_vector_type(16)));
typedef unsigned u32x2 __attribute__((ext_vector_type(2)));
typedef unsigned u32x4 __attribute__((ext_vector_type(4)));
typedef int i32x4 __attribute__((ext_vector_type(4)));
typedef int i32x8 __attribute__((ext_vector_type(8)));

constexpr int T = 16384, DM = 2048, SEQ = 2048, NBATCH = 8, MEMLEN = 256;
constexpr int INW = 2880, INWP = 3072, GW = 1024, QL = 512, KVL = 256, ROPE = 64;
constexpr int NQ = 1536, NKV = 2048, NEXP = 64, DE = 512, CAP = 16384;
constexpr float EPS = 1e-6f;

typedef __bf16 bf16x2_t __attribute__((ext_vector_type(2)));
__device__ __forceinline__ unsigned cvt_pk_bf16(float lo, float hi) { const f32x2 v = {lo, hi}; const bf16x2_t b = __builtin_convertvector(v, bf16x2_t); return __builtin_bit_cast(unsigned, b); }
__device__ __forceinline__ u32x4 pack8(const f32x4 a, const f32x4 b) { u32x4 w; w.x = cvt_pk_bf16(a[0], a[1]); w.y = cvt_pk_bf16(a[2], a[3]); w.z = cvt_pk_bf16(b[0], b[1]); w.w = cvt_pk_bf16(b[2], b[3]); return w; }
__device__ __forceinline__ u32x2 pack8_fp8(const f32x4 a, const f32x4 b) {
    int lo = __builtin_amdgcn_cvt_pk_fp8_f32(a[0], a[1], 0, false); lo = __builtin_amdgcn_cvt_pk_fp8_f32(a[2], a[3], lo, true);
    int hi = __builtin_amdgcn_cvt_pk_fp8_f32(b[0], b[1], 0, false); hi = __builtin_amdgcn_cvt_pk_fp8_f32(b[2], b[3], hi, true);
    return (u32x2){(unsigned)lo, (unsigned)hi};
}
__device__ __forceinline__ float bf_lo(unsigned w) { return __uint_as_float(w << 16); }
__device__ __forceinline__ float bf_hi(unsigned w) { return __uint_as_float(w & 0xffff0000u); }
__device__ __forceinline__ float gelu_tanh(float x) {
    const float u2 = 1.5957691216057308f * (x + 0.044715f * x * x * x);
    return x * __builtin_amdgcn_rcpf(1.0f + __builtin_amdgcn_exp2f(-1.4426950408889634f * u2));
}
__device__ __forceinline__ float silu_f(float x) { return x * __builtin_amdgcn_rcpf(1.0f + __builtin_amdgcn_exp2f(-1.4426950408889634f * x)); }
__device__ __forceinline__ float fq_reduce(float s) { s += __shfl_xor(s, 16); s += __shfl_xor(s, 32); return s; }
__device__ __forceinline__ float wave_sum(float v) {
#pragma unroll
    for (int o = 1; o < 64; o <<= 1) v += __shfl_xor(v, o);
    return v;
}
typedef unsigned long long stat_t;
__device__ __forceinline__ void stat_add(stat_t* p, float v) { atomicAdd(p, (stat_t)(long long)(v * 4294967296.0f)); }
__device__ __forceinline__ float stat_get(const stat_t* p) { return (float)((double)(long long)(*p) * 2.3283064365386963e-10); }
__device__ __forceinline__ float rstd_of(float ssq, float inv_n) { return 1.0f / sqrtf(ssq * inv_n + EPS); }

namespace pg8 {
constexpr int BM = 256, BK = 64, HALF = 128, HTB = HALF * BK * 2, STAGE_BYTES = 8 * HTB, NXCD = 8, WGM = 8;
__host__ __device__ __forceinline__ int lds_byte(int r, int c) { const int st = (r >> 4) * 2 + (c >> 5), rr = r & 15, cc = c & 31, ob = rr * 64 + cc * 2; return st * 1024 + (ob ^ (((ob >> 9) & 1) << 5)); }
__host__ __device__ __forceinline__ void stage_rc(int b, int& R, int& C) { const int st = b / 1024, sb = b % 1024, swz = sb ^ (((sb >> 9) & 1) << 5); R = (st >> 1) * 16 + swz / 64; C = (st & 1) * 32 + (swz % 64) / 2; }
__host__ __device__ __forceinline__ int perm32(int rho) { const int n = rho >> 4, i = rho & 15; return 8 * (i >> 2) + 4 * n + (i & 3); }

struct Unit { int pm, pn, e, j; unsigned koff; int full; int roff; };
struct Gemm { const bf16_t* A; const bf16_t* Bt; int K, lda, ldb; };

struct StaticOrder {
    static constexpr bool LAZY_A = false, LINEAR_A = true;
    int nM, nN, nwg, G, c;
    __device__ void init(int M, int N, int G_, int c_) { nM = M / BM; nN = N / BM; nwg = nM * nN; G = G_; c = c_; }
    __device__ bool next(int i, Unit& u) const {
        const long L = (long)i * G + c; if (L >= nwg) return false;
        int wgid = (int)L; { const int q = nwg / NXCD, r = nwg % NXCD, xcd = wgid % NXCD, off = wgid / NXCD; wgid = (xcd < r ? xcd * (q + 1) : r * (q + 1) + (xcd - r) * q) + off; }
        const int nig = WGM * nN, gid = wgid / nig, fm = gid * WGM, gsz = (nM - fm) < WGM ? (nM - fm) : WGM;
        u.pm = fm + ((wgid % nig) % gsz); u.pn = (wgid % nig) / gsz; u.e = 0; u.j = 0; u.koff = 0u; u.full = 1; u.roff = 0; return true;
    }
    __device__ __forceinline__ int arow(const Unit& u, int r) const { return u.pm * BM + r; }
};

struct SubOrder {
    static constexpr bool LAZY_A = false, LINEAR_A = true;
    StaticOrder base; int i0, i1;
    __device__ bool next(int i, Unit& u) const { return (i0 + i < i1) && base.next(i0 + i, u); }
    __device__ __forceinline__ int arow(const Unit& u, int r) const { return u.pm * BM + r; }
};
__device__ __forceinline__ const char* uptr(const char* p) {
    const unsigned long long v = (unsigned long long)p;
    const unsigned lo = __builtin_amdgcn_readfirstlane((unsigned)v), hi = __builtin_amdgcn_readfirstlane((unsigned)(v >> 32));
    return (const char*)(((unsigned long long)hi << 32) | lo);
}
template <class E, class = void> struct EpiInit { static constexpr bool v = false; };
template <class E> struct EpiInit<E, decltype((void)E::ACCINIT)> { static constexpr bool v = E::ACCINIT; };
template <class E, class = void> struct EpiF8 { static constexpr bool v = false; };
template <class E> struct EpiF8<E, decltype((void)E::F8)> { static constexpr bool v = E::F8; };
__device__ __forceinline__ i32x8 cat8(const bf16x8 a, const bf16x8 b) { return __builtin_shufflevector(__builtin_bit_cast(i32x4, a), __builtin_bit_cast(i32x4, b), 0, 1, 2, 3, 4, 5, 6, 7); }
template <class Epi, class Sched>
__device__ __forceinline__ void gemm_phase(LAS unsigned char* lds, const Gemm g, const Sched& S, const Epi& E) {
    constexpr bool F8 = EpiF8<Epi>::v;
    int tid_ = threadIdx.x; asm volatile("" : "+v"(tid_));
    int tid = tid_; const int wid = __builtin_amdgcn_readfirstlane(tid >> 6), wr = wid >> 2, wc = wid & 3;
    int lane, fr, fq, aoff, boff;
    const int K = g.K, nt = K / BK;
    unsigned voffB0; int RA0; unsigned CA0;
#define PG8_LANE() do { tid = (int)threadIdx.x; asm volatile("" : "+v"(tid)); lane = tid & 63; fr = lane & 15; fq = lane >> 4; \
    { int R, C; stage_rc(tid * 16, R, C); RA0 = R; CA0 = (unsigned)C * 2u; voffB0 = (unsigned)(((R & ~31) + perm32(R & 31)) * g.ldb + C) * 2u; } \
    aoff = lds_byte(wr * 64 + fr, fq * 8); boff = lds_byte(wc * 32 + fr, fq * 8); } while (0)
    PG8_LANE();
    const unsigned rowb = (unsigned)g.lda * 2u;
    const size_t kstep = (size_t)(BK * 2);
    const size_t hstep = (size_t)HALF * g.ldb * 2;
    const size_t tstep = 2 * hstep;
    const unsigned ldsw = (unsigned)wid * 1024u;
    const size_t dB64 = (size_t)64 * g.ldb * 2, dA64 = (size_t)64 * g.lda * 2;
#define PG8_SA(b, h) (((b) * 2 + (h)) * HTB)
#define PG8_SB(b, h) ((4 + (b) * 2 + (h)) * HTB)
#define PG8_STAGE(bufoff, gbase, voff) do { const char* _gb = (const char*)(gbase); unsigned _vo = voffB0; asm volatile("" : "+s"(_gb), "+v"(_vo)); \
        __builtin_amdgcn_global_load_lds((const unsigned*)(_gb + _vo), (LAS unsigned*)(lds + (bufoff) + ldsw), 16, 0, 0); \
        __builtin_amdgcn_global_load_lds((const unsigned*)(_gb + dB64 + _vo), (LAS unsigned*)(lds + (bufoff) + ldsw + 8192), 16, 0, 0); } while (0)
#define PG8_STAGE_A(bufoff, kbyte, o0, o1) do { unsigned _o0 = (o0), _o1 = Sched::LINEAR_A ? 0u : (o1); const char* _ab = (const char*)g.A + (kbyte); asm volatile("" : "+v"(_o0), "+v"(_o1), "+s"(_ab)); \
        __builtin_amdgcn_global_load_lds((const unsigned*)(_ab + _o0), (LAS unsigned*)(lds + (bufoff) + ldsw), 16, 0, 0); \
        if constexpr (Sched::LINEAR_A) __builtin_amdgcn_global_load_lds((const unsigned*)(_ab + dA64 + _o0), (LAS unsigned*)(lds + (bufoff) + ldsw + 8192), 16, 0, 0); \
        else __builtin_amdgcn_global_load_lds((const unsigned*)(_ab + _o1), (LAS unsigned*)(lds + (bufoff) + ldsw + 8192), 16, 0, 0); } while (0)
#define PG8_LDA(dst, b, h) do { _Pragma("unroll") for (int m = 0; m < 4; ++m) _Pragma("unroll") for (int k = 0; k < 2; ++k) dst[m][k] = *(const LAS bf16x8*)(lds + PG8_SA(b, h) + aoff + m * 2048 + k * 1024); } while (0)
#define PG8_LDB(dst, b, h) do { _Pragma("unroll") for (int n = 0; n < 2; ++n) _Pragma("unroll") for (int k = 0; k < 2; ++k) dst[n][k] = *(const LAS bf16x8*)(lds + PG8_SB(b, h) + boff + n * 2048 + k * 1024); } while (0)
#define PG8_MMA(ai, bj, At, Bt) do { __builtin_amdgcn_s_setprio(1); _Pragma("unroll") for (int m = 0; m < 4; ++m) _Pragma("unroll") for (int n = 0; n < 2; ++n) { \
        if constexpr (F8) acc[ai][bj][m][n] = __builtin_amdgcn_mfma_scale_f32_16x16x128_f8f6f4(cat8(Bt[n][0], Bt[n][1]), cat8(At[m][0], At[m][1]), acc[ai][bj][m][n], 0, 0, 0, 0, 0, 0); \
        else { _Pragma("unroll") for (int k = 0; k < 2; ++k) acc[ai][bj][m][n] = __builtin_amdgcn_mfma_f32_16x16x32_bf16(Bt[n][k], At[m][k], acc[ai][bj][m][n], 0, 0, 0); } } __builtin_amdgcn_s_setprio(0); } while (0)
#define PG8_WAIT_V(n) asm volatile("s_waitcnt vmcnt(" #n ")" ::: "memory")
#define PG8_WAIT_L(n) asm volatile("s_waitcnt lgkmcnt(" #n ")" ::: "memory")
#define PG8_BAR __builtin_amdgcn_s_barrier()
#define PG8_SCHED __builtin_amdgcn_sched_barrier(0)
#define PG8_AOFFS(u, o00, o01, o10, o11) do { o00 = (unsigned)S.arow(u, RA0) * rowb + CA0 + (u).koff; o10 = (unsigned)S.arow(u, HALF + RA0) * rowb + CA0 + (u).koff; \
        if constexpr (!Sched::LINEAR_A) { o01 = (unsigned)S.arow(u, RA0 + 64) * rowb + CA0 + (u).koff; o11 = (unsigned)S.arow(u, HALF + RA0 + 64) * rowb + CA0 + (u).koff; } else { o01 = 0u; o11 = 0u; } } while (0)
    Unit cur, nxt; int ui = 0;
    if (!S.next(0, cur)) return;
    f32x4 acc[2][2][4][2];
#pragma unroll
    for (int a = 0; a < 2; ++a)
#pragma unroll
        for (int b = 0; b < 2; ++b)
#pragma unroll
            for (int m = 0; m < 4; ++m)
#pragma unroll
                for (int n = 0; n < 2; ++n) acc[a][b][m][n] = (f32x4){0.f, 0.f, 0.f, 0.f};
    if constexpr (EpiInit<Epi>::v) E.init(acc, cur, wr, wc, fr, fq);
    bf16x8 At[4][2], B0[2][2], B1[2][2];
    unsigned ca00, ca01, ca10, ca11, na00, na01, na10, na11;
    PG8_AOFFS(cur, ca00, ca01, ca10, ca11);
#define PG8_TAB(par) ((LAS float*)(lds + STAGE_BYTES + ((par) & 1) * 4096))
    if constexpr (Epi::PREP) E.prep(cur, PG8_TAB(0), tid);
    const char* cB = uptr((const char*)g.Bt + (size_t)cur.pn * tstep + cur.koff);
    PG8_STAGE(PG8_SB(0, 0), cB, 0); PG8_STAGE(PG8_SB(0, 1), cB + hstep, 0); PG8_STAGE_A(PG8_SA(0, 0), 0, ca00, ca01); PG8_STAGE_A(PG8_SA(0, 1), 0, ca10, ca11);
    if (wr == 1) PG8_BAR;
    PG8_WAIT_V(2); PG8_BAR;
    PG8_STAGE(PG8_SB(1, 0), cB + kstep, 0); PG8_STAGE_A(PG8_SA(1, 0), kstep, ca00, ca01); PG8_STAGE(PG8_SB(1, 1), cB + hstep + kstep, 0);
    PG8_WAIT_V(6); PG8_BAR;
    for (;;) {
        const bool has_next = S.next(ui + 1, nxt);
        const char* nB = uptr(has_next ? (const char*)g.Bt + (size_t)nxt.pn * tstep + nxt.koff : cB);
        if constexpr (!Sched::LAZY_A) { if (has_next) { PG8_AOFFS(nxt, na00, na01, na10, na11); } else { na00 = ca00; na01 = ca01; na10 = ca10; na11 = ca11; } }
#pragma unroll 1
        for (int t = 0; t < nt; t += 2) {
            const bool last = (t == nt - 2);
            if constexpr (Epi::MID) { if (t == (nt >> 1)) E.mid(acc, cur, wr, fr, PG8_TAB(ui)); }
            const size_t kb1 = (size_t)(t + 1) * kstep;
            const size_t kb2 = last ? (size_t)0 : (size_t)(t + 2) * kstep, kb3 = kb2 + kstep;
            const char* b2 = last ? nB : cB + (size_t)(t + 2) * kstep; const char* b3 = b2 + kstep;
            unsigned s00 = ca00, s01 = ca01, s10 = ca10, s11 = ca11;
            if constexpr (Sched::LAZY_A) { if (last && has_next) { PG8_AOFFS(nxt, s00, s01, s10, s11); } }
            else { if (last) { s00 = na00; s01 = na01; s10 = na10; s11 = na11; } }
            PG8_LDB(B0, 0, 0); PG8_LDB(B1, 0, 1); PG8_SCHED; PG8_LDA(At, 0, 0); PG8_STAGE_A(PG8_SA(1, 1), kb1, ca10, ca11);
            PG8_WAIT_V(8); PG8_WAIT_L(0); PG8_BAR; PG8_MMA(0, 0, At, B0); PG8_MMA(0, 1, At, B1); PG8_BAR; PG8_SCHED;
            PG8_LDA(At, 0, 1); PG8_STAGE(PG8_SB(0, 0), b2, 0); PG8_STAGE(PG8_SB(0, 1), b2 + hstep, 0); PG8_STAGE_A(PG8_SA(0, 0), kb2, s00, s01);
            PG8_WAIT_V(8); PG8_WAIT_L(0); PG8_BAR; if (cur.full) { PG8_MMA(1, 0, At, B0); PG8_MMA(1, 1, At, B1); } PG8_BAR; PG8_SCHED;
            PG8_LDB(B0, 1, 0); PG8_LDB(B1, 1, 1); PG8_SCHED; PG8_LDA(At, 1, 0); PG8_STAGE_A(PG8_SA(0, 1), kb2, s10, s11);
            PG8_WAIT_V(8); PG8_WAIT_L(0); PG8_BAR; PG8_MMA(0, 0, At, B0); PG8_MMA(0, 1, At, B1); PG8_BAR; PG8_SCHED;
            PG8_LDA(At, 1, 1); PG8_STAGE(PG8_SB(1, 0), b3, 0); PG8_STAGE(PG8_SB(1, 1), b3 + hstep, 0); PG8_STAGE_A(PG8_SA(1, 0), kb3, s00, s01);
            PG8_WAIT_V(8); PG8_WAIT_L(0); PG8_BAR; if (cur.full) { PG8_MMA(1, 0, At, B0); PG8_MMA(1, 1, At, B1); } PG8_BAR; PG8_SCHED;
        }
        if (wr == 0) PG8_BAR;
        int l_e = (int)threadIdx.x & 63; asm volatile("" : "+v"(l_e)); const int fr_e = l_e & 15, fq_e = l_e >> 4;
        if constexpr (Epi::PREP) { E(acc, cur, wr, wc, fr_e, fq_e, PG8_TAB(ui)); if (has_next) E.prep(nxt, PG8_TAB(ui + 1), tid); }
        else if constexpr (!Epi::AFTER) E(acc, cur, wr, wc, fr_e, fq_e);
        if (!has_next) break;
#pragma unroll
        for (int a = 0; a < 2; ++a)
#pragma unroll
            for (int b = 0; b < 2; ++b)
#pragma unroll
                for (int m = 0; m < 4; ++m)
#pragma unroll
                    for (int n = 0; n < 2; ++n) acc[a][b][m][n] = (f32x4){0.f, 0.f, 0.f, 0.f};
        if constexpr (EpiInit<Epi>::v) E.init(acc, nxt, wr, wc, fr_e, fq_e);
        cur = nxt; cB = nB; ++ui;
        PG8_LANE();
        if constexpr (Sched::LAZY_A) { PG8_AOFFS(cur, ca00, ca01, ca10, ca11); } else { ca00 = na00; ca01 = na01; ca10 = na10; ca11 = na11; }
        if (wr == 1) PG8_BAR;
    }
    PG8_WAIT_V(0);
    PG8_BAR;
    if constexpr (Epi::AFTER) E.after(acc, cur, wr, wc, fr, fq, lds, tid);
#undef PG8_LANE
#undef PG8_SA
#undef PG8_SB
#undef PG8_STAGE
#undef PG8_STAGE_A
#undef PG8_LDA
#undef PG8_LDB
#undef PG8_MMA
#undef PG8_WAIT_V
#undef PG8_WAIT_L
#undef PG8_BAR
#undef PG8_SCHED
#undef PG8_AOFFS
#undef PG8_TAB
}
}
using pg8::Unit;

constexpr size_t MiB = 1u << 20;
constexpr size_t WS_CTL = 0, CTL_ZERO_BYTES = 2 * MiB;
constexpr int CW_BAR = 4096;
constexpr int CW_CNT = 8192;
constexpr int CW_STAT = 16384;
enum { ST_VSUM = 0, ST_VSQ, ST_Q, ST_KV, ST_A, ST_M, ST_X1, ST_X2, ST_N };
static_assert((size_t)CW_STAT * 4 + (size_t)ST_N * T * 8 <= CTL_ZERO_BYTES, "ctl");
constexpr size_t al(size_t x) { return (x + 4095) / 4096 * 4096; }
constexpr size_t WS_WIN = CTL_ZERO_BYTES;
constexpr size_t WS_WUQ = WS_WIN + al((size_t)INWP * DM * 2);
constexpr size_t WS_WUKV = WS_WUQ + al((size_t)NQ * QL * 2);
constexpr size_t WS_WOA = WS_WUKV + al((size_t)NKV * KVL * 2);
constexpr size_t WS_WOM = WS_WOA + al((size_t)DM * GW * 2);
constexpr size_t WS_WMQ = WS_WOM + al((size_t)DM * GW * 2);
constexpr size_t WS_WMKV = WS_WMQ + al((size_t)512 * DM * 2);
constexpr size_t WS_WMO = WS_WMKV + al((size_t)1024 * DM * 2);
constexpr size_t WS_WR = WS_WMO + al((size_t)DM * 512 * 2);
constexpr size_t WS_RB = WS_WR + al((size_t)256 * DM * 2);
constexpr size_t WS_COS = WS_RB + al(1024);
constexpr size_t WS_SIN = WS_COS + al((size_t)SEQ * 32 * 4);
constexpr size_t WS_WGU = WS_SIN + al((size_t)SEQ * 32 * 4);
constexpr size_t WS_X8 = WS_WGU + (size_t)NEXP * 1024 * DM;
constexpr size_t WS_WD = WS_WGU + al((size_t)NEXP * 1024 * DM * 2);
constexpr size_t WS_HB = WS_WD + al((size_t)NEXP * DM * DE * 2);
constexpr size_t WS_UV = WS_HB + al((size_t)(T + 1) * DM * 2);
constexpr size_t WS_KV = WS_UV + al((size_t)T * DM * 2);
constexpr size_t WS_YS = WS_UV;
constexpr size_t WS_LOGP = WS_UV;
constexpr size_t WS_Q = WS_KV + al((size_t)T * NKV * 2);
constexpr size_t WS_H = WS_UV + (size_t)49152 * DM * 2;
constexpr size_t WS_CQ = WS_Q + al((size_t)49152 * DE * 2);
constexpr size_t WS_CKV = WS_CQ + al((size_t)T * QL * 2);
constexpr size_t WS_KR = WS_CKV + al((size_t)T * KVL * 2);
constexpr size_t WS_AB = WS_KR + al((size_t)T * ROPE * 2);
constexpr size_t WS_MB = WS_AB + al((size_t)T * GW * 2);
constexpr size_t WS_MEMN = WS_MB + al((size_t)T * GW * 2);
constexpr size_t WS_MKV = WS_MEMN + al((size_t)NBATCH * MEMLEN * DM * 2);
constexpr size_t WS_XQ = WS_MKV + al((size_t)NBATCH * MEMLEN * 1024 * 2);
constexpr size_t WS_XO = WS_XQ + al((size_t)T * 512 * 2);
constexpr size_t WS_LOG = WS_XO + al((size_t)T * 512 * 2);
constexpr size_t WS_TOKW = WS_LOG + al((size_t)T * 128 * 4);
constexpr size_t WS_ROWTOK = WS_TOKW + al((size_t)T * 2 * 4);
constexpr size_t WS_TOKE = WS_ROWTOK + al((size_t)NEXP * CAP * 4);
constexpr size_t WS_WSPB = WS_TOKE + al((size_t)T * 2 * 4);
constexpr size_t WS_RSTDX = WS_WSPB + al((size_t)8 * 128 * 128 * 2);
constexpr size_t WS_GINV = WS_RSTDX + al((size_t)T * 4);
constexpr size_t WS_WMOB = WS_GINV + al((size_t)DM * 4);
constexpr size_t WS_W2T = WS_WMOB + al((size_t)512 * DM * 2);
constexpr size_t WS_END = WS_W2T + al((size_t)256 * 512 * 2);
constexpr size_t WS_LOG1 = WS_UV;
static_assert(WS_UV + (size_t)49152 * DM * 2 + (size_t)49152 * DE * 2 <= WS_UV + (size_t)T * DM * 2 * 2 + (size_t)49152 * DE * 2 + (size_t)T * (QL + KVL + ROPE + 2 * GW) * 2, "YS | H inside the dead UV..MB span");
static_assert((size_t)T * NQ * 2 <= (size_t)49152 * DE * 2, "H overlays Q");

constexpr int RING_BYTES = 131072, MISC_OFF = 143360, TS_OFF = 143360 + 512, LDS_BYTES = 147456;

#define XB_TMO      128
#define XB_XCNT(j)  (256  + 64 * (j))
#define XB_XSUB(j)  (1280 + 64 * (j))
#define XB_XGEN(j)  (2304 + 64 * (j))
#define XB_TOP      3328
#define XB_TOPGEN   3392
#define XCD_BAR_WORDS 3456
#define XB_SPIN_CAP (1u << 18)
__device__ __forceinline__ unsigned xb_ld(unsigned* p)              { return __hip_atomic_load(p, __ATOMIC_RELAXED, __HIP_MEMORY_SCOPE_AGENT); }
__device__ __forceinline__ unsigned xb_add(unsigned* p, unsigned v) { return __hip_atomic_fetch_add(p, v, __ATOMIC_RELAXED, __HIP_MEMORY_SCOPE_AGENT); }
__device__ __forceinline__ unsigned xb_xcc_id() { return (unsigned)__builtin_amdgcn_s_getreg((3 << 11) | 20) & 0xFu; }
#define XB_SPIN(cond, bar) do { unsigned _sp = 0; while (cond) { __builtin_amdgcn_s_sleep(1); \
    if ((++_sp & 255u) == 0u) { if (xb_ld(&(bar)[XB_TMO])) break; if (_sp > XB_SPIN_CAP) { atomicAdd(&(bar)[XB_TMO], 1u); break; } } } } while (0)
struct XcdBarrier { unsigned* bar; unsigned x; volatile LAS unsigned* st; };
__device__ __forceinline__ XcdBarrier xcd_barrier_post(unsigned* bar, volatile LAS unsigned* st) {
    XcdBarrier b; b.bar = bar; b.x = xb_xcc_id(); b.st = st;
    if (threadIdx.x == 0) (void)xb_add(&bar[XB_XCNT(b.x)], 1u);
    return b;
}
__device__ __forceinline__ void xcd_barrier_complete(unsigned* bar, unsigned x, unsigned& nloc, unsigned& nx) {
    const unsigned G = gridDim.x * gridDim.y * gridDim.z;
    unsigned sum, cnt, mine, sp = 0u;
    for (;;) {
        sum = 0u; cnt = 0u; mine = 0u;
#pragma unroll
        for (unsigned j = 0; j < 16; ++j) { const unsigned c = xb_ld(&bar[XB_XCNT(j)]); sum += c; cnt += (c > 0u) ? 1u : 0u; mine = (j == x) ? c : mine; }
        if (sum == G) break;
        __builtin_amdgcn_s_sleep(1);
        if ((++sp & 255u) == 0u) { if (xb_ld(&bar[XB_TMO])) break; if (sp > XB_SPIN_CAP) { atomicAdd(&bar[XB_TMO], 1u); break; } }
    }
    nloc = mine > 0u ? mine : 1u; nx = cnt > 0u ? cnt : 1u;
}
__device__ __forceinline__ void xcd_barrier(const XcdBarrier& b) {
    asm volatile("s_waitcnt vmcnt(0)" ::: "memory");
    __syncthreads();
    if (threadIdx.x == 0) {
        unsigned* bar = b.bar;
        __builtin_amdgcn_s_waitcnt(0);
        unsigned nloc = b.st[0], nx = b.st[1];
        if (nloc == 0u) { xcd_barrier_complete(bar, b.x, nloc, nx); b.st[0] = nloc; b.st[1] = nx; }
        const unsigned old = xb_add(&bar[XB_XSUB(b.x)], 1u);
        const unsigned gen = old / nloc;
        if (old + 1u == (gen + 1u) * nloc) {
            __builtin_amdgcn_fence(__ATOMIC_RELEASE, "agent");
            asm volatile("s_waitcnt vmcnt(0)" ::: "memory");
            const unsigned og = xb_add(&bar[XB_TOP], 1u);
            const unsigned tg = og / nx;
            if (og + 1u == (tg + 1u) * nx) xb_add(&bar[XB_TOPGEN], 1u);
            else XB_SPIN(xb_ld(&bar[XB_TOPGEN]) == tg, bar);
            __builtin_amdgcn_fence(__ATOMIC_ACQUIRE, "agent");
            xb_add(&bar[XB_XGEN(b.x)], 1u);
            asm volatile("s_waitcnt vmcnt(0)" ::: "memory");
        } else {
            XB_SPIN(xb_ld(&bar[XB_XGEN(b.x)]) == gen, bar);
            __builtin_amdgcn_fence(__ATOMIC_ACQUIRE, "agent");
            asm volatile("s_waitcnt vmcnt(0)" ::: "memory");
        }
    }
    __syncthreads();
}

struct Frame {
    LAS unsigned char* lds;
    int tid, lane, wave, vcu, G;
    const float* in[30];
    float* out; unsigned char* ws;
    unsigned* ctl;
};
#define WSP(T_, off) ((T_*)(F.ws + (off)))
#define STAT(F, k) ((stat_t*)((F).ctl + CW_STAT) + (size_t)(k) * T)

#define EPI_ROWS_BEGIN _Pragma("unroll") for (int ai = 0; ai < 2; ++ai) _Pragma("unroll") for (int m = 0; m < 4; ++m) { const int rl = ai * 128 + wr * 64 + m * 16 + fr; const int row = u.pm * 256 + rl; (void)row;
#define EPI_ROWS_END }

struct EpiZ {
    static constexpr bool MID = false, AFTER = false, PREP = false;
    bf16_t *UV, *CQ, *CKV, *KR; stat_t *vsum, *vsq, *ssq_q, *ssq_kv; const float *cosT, *sinT;
    __device__ __forceinline__ void operator()(const f32x4 (&acc)[2][2][4][2], const Unit& u, int wr, int wc, int fr, int fq) const {
        const int pn = u.pn, cl = wc * 32 + 8 * fq;
        EPI_ROWS_BEGIN
            if (pn < 8) {
                float s1 = 0.f, s2 = 0.f;
#pragma unroll
                for (int bj = 0; bj < 2; ++bj) {
                    f32x4 v0 = acc[ai][bj][m][0], v1 = acc[ai][bj][m][1];
#pragma unroll
                    for (int k = 0; k < 4; ++k) { v0[k] = gelu_tanh(v0[k]); v1[k] = gelu_tanh(v1[k]); }
                    *(u32x4*)(UV + (size_t)row * DM + pn * 256 + bj * 128 + cl) = pack8(v0, v1);
#pragma unroll
                    for (int k = 0; k < 4; ++k) { s1 += v0[k] + v1[k]; s2 += v0[k] * v0[k] + v1[k] * v1[k]; }
                }
                if (pn >= 4) { s1 = fq_reduce(s1); s2 = fq_reduce(s2); if (fq == 0) { stat_add(vsum + row, s1); stat_add(vsq + row, s2); } }
            } else if (pn < 11) {
                float s2 = 0.f;
#pragma unroll
                for (int bj = 0; bj < 2; ++bj) {
                    const f32x4 v0 = acc[ai][bj][m][0], v1 = acc[ai][bj][m][1];
                    if (pn < 10) *(u32x4*)(CQ + (size_t)row * QL + (pn - 8) * 256 + bj * 128 + cl) = pack8(v0, v1);
                    else *(u32x4*)(CKV + (size_t)row * KVL + bj * 128 + cl) = pack8(v0, v1);
#pragma unroll
                    for (int k = 0; k < 4; ++k) s2 += v0[k] * v0[k] + v1[k] * v1[k];
                }
                s2 = fq_reduce(s2);
                if (fq == 0) stat_add((pn < 10 ? ssq_q : ssq_kv) + row, s2);
            } else if (wc < 2) {
                const int pos = row & (SEQ - 1), i0 = cl >> 1;
                const unsigned to = (unsigned)((pos * 32 + i0) * 4);
                const f32x4 cs = *(const f32x4*)((const char*)cosT + to), sn = *(const f32x4*)((const char*)sinT + to);
                const f32x4 v0 = acc[ai][0][m][0], v1 = acc[ai][0][m][1];
                f32x4 o0, o1;
                o0[0] = v0[0] * cs[0] - v0[1] * sn[0]; o0[1] = v0[1] * cs[0] + v0[0] * sn[0];
                o0[2] = v0[2] * cs[1] - v0[3] * sn[1]; o0[3] = v0[3] * cs[1] + v0[2] * sn[1];
                o1[0] = v1[0] * cs[2] - v1[1] * sn[2]; o1[1] = v1[1] * cs[2] + v1[0] * sn[2];
                o1[2] = v1[2] * cs[3] - v1[3] * sn[3]; o1[3] = v1[3] * cs[3] + v1[2] * sn[3];
                *(u32x4*)(KR + (size_t)row * ROPE + cl) = pack8(o0, o1);
            }
        EPI_ROWS_END
    }
};
struct EpiQ {
    static constexpr bool MID = false, AFTER = false, PREP = true;
    bf16_t* Q; const stat_t* ssq_q; const float *cosT, *sinT;
    __device__ __forceinline__ void prep(const Unit& u, LAS float* tab, int tid) const { if (tid < 256) tab[tid] = rstd_of(stat_get(ssq_q + u.pm * 256 + tid), 1.0f / QL); }
    __device__ __forceinline__ void operator()(const f32x4 (&acc)[2][2][4][2], const Unit& u, int wr, int wc, int fr, int fq, const LAS float* tab) const {
        EPI_ROWS_BEGIN
            const float rs = tab[rl];
            const int pos = row & (SEQ - 1);
#pragma unroll
            for (int bj = 0; bj < 2; ++bj) {
                const int c0 = u.pn * 256 + bj * 128 + wc * 32 + 8 * fq, dd = c0 % 192;
                f32x4 v0 = acc[ai][bj][m][0] * rs, v1 = acc[ai][bj][m][1] * rs;
                if (dd >= 128) {
                    const int i0 = (dd - 128) >> 1;
                    const unsigned to = (unsigned)((pos * 32 + i0) * 4);
                    const f32x4 cs = *(const f32x4*)((const char*)cosT + to), sn = *(const f32x4*)((const char*)sinT + to);
                    f32x4 o0, o1;
                    o0[0] = v0[0] * cs[0] - v0[1] * sn[0]; o0[1] = v0[1] * cs[0] + v0[0] * sn[0];
                    o0[2] = v0[2] * cs[1] - v0[3] * sn[1]; o0[3] = v0[3] * cs[1] + v0[2] * sn[1];
                    o1[0] = v1[0] * cs[2] - v1[1] * sn[2]; o1[1] = v1[1] * cs[2] + v1[0] * sn[2];
                    o1[2] = v1[2] * cs[3] - v1[3] * sn[3]; o1[3] = v1[3] * cs[3] + v1[2] * sn[3];
                    v0 = o0; v1 = o1;
                }
                *(u32x4*)(Q + (size_t)row * NQ + c0) = pack8(v0, v1);
            }
        EPI_ROWS_END
    }
};
struct EpiScaleBf16 {
    static constexpr bool MID = false, AFTER = false, PREP = true;
    bf16_t* O; int ldo; const stat_t* ssq; float inv_n;
    __device__ __forceinline__ void prep(const Unit& u, LAS float* tab, int tid) const { if (tid < 256) tab[tid] = ssq ? rstd_of(stat_get(ssq + u.pm * 256 + tid), inv_n) : 1.0f; }
    __device__ __forceinline__ void operator()(const f32x4 (&acc)[2][2][4][2], const Unit& u, int wr, int wc, int fr, int fq, const LAS float* tab) const {
        EPI_ROWS_BEGIN
            const float rs = tab[rl];
#pragma unroll
            for (int bj = 0; bj < 2; ++bj)
                *(u32x4*)(O + (size_t)row * ldo + u.pn * 256 + bj * 128 + wc * 32 + 8 * fq) = pack8(acc[ai][bj][m][0] * rs, acc[ai][bj][m][1] * rs);
        EPI_ROWS_END
    }
};
struct EpiScaleF8 {
    static constexpr bool MID = false, AFTER = false, PREP = false;
    unsigned char* O; int ldo; float scale;
    __device__ __forceinline__ void operator()(const f32x4 (&acc)[2][2][4][2], const Unit& u, int wr, int wc, int fr, int fq) const {
        EPI_ROWS_BEGIN
#pragma unroll
            for (int bj = 0; bj < 2; ++bj)
                *(u32x2*)(O + (size_t)row * ldo + u.pn * 256 + bj * 128 + wc * 32 + 8 * fq) = pack8_fp8(acc[ai][bj][m][0] * scale, acc[ai][bj][m][1] * scale);
        EPI_ROWS_END
    }
};
struct EpiMix {
    static constexpr bool MID = true, AFTER = false, PREP = true;
    const float* rstdx; const stat_t* ssq_a; const stat_t* ssq_m; bf16_t* XB; stat_t* ssq_out;
    __device__ __forceinline__ void prep(const Unit& u, LAS float* tab, int tid) const {
        if (tid < 256) { const int row = u.pm * 256 + tid;
            const float ra = rstd_of(stat_get(ssq_a + row), 1.0f / GW), rm = rstd_of(stat_get(ssq_m + row), 1.0f / GW);
            *(LAS f32x4*)(tab + tid * 4) = (f32x4){ra / rm, rm, 1.0f / rstdx[row], 0.f}; }
    }
    __device__ __forceinline__ void mid(f32x4 (&acc)[2][2][4][2], const Unit& u, int wr, int fr, const LAS float* tab) const {
#pragma unroll
        for (int ai = 0; ai < 2; ++ai)
#pragma unroll
            for (int m = 0; m < 4; ++m) { const float f = tab[(ai * 128 + wr * 64 + m * 16 + fr) * 4];
#pragma unroll
                for (int bj = 0; bj < 2; ++bj) { acc[ai][bj][m][0] *= f; acc[ai][bj][m][1] *= f; } }
    }
    __device__ __forceinline__ void operator()(const f32x4 (&acc)[2][2][4][2], const Unit& u, int wr, int wc, int fr, int fq, const LAS float* tab) const {
        u32x4 wl[2][4][2];
        const int colb = u.pn * 256 + wc * 32 + 8 * fq;
#pragma unroll
        for (int ai = 0; ai < 2; ++ai)
#pragma unroll
            for (int m = 0; m < 4; ++m)
#pragma unroll
                for (int bj = 0; bj < 2; ++bj) wl[ai][m][bj] = *(const u32x4*)(XB + (size_t)(u.pm * 256 + ai * 128 + wr * 64 + m * 16 + fr) * DM + colb + bj * 128);
        asm volatile("" ::: "memory");
        EPI_ROWS_BEGIN
            const float rs = tab[rl * 4 + 1], rx = tab[rl * 4 + 2];
            float s2 = 0.f;
#pragma unroll
            for (int bj = 0; bj < 2; ++bj) {
                const int col = colb + bj * 128;
                const size_t off = (size_t)row * DM + col;
                const u32x4 w = wl[ai][m][bj];
                const f32x4 b0 = (f32x4){bf_lo(w.x), bf_hi(w.x), bf_lo(w.y), bf_hi(w.y)} * rx, b1 = (f32x4){bf_lo(w.z), bf_hi(w.z), bf_lo(w.w), bf_hi(w.w)} * rx;
                const f32x4 v0 = b0 + acc[ai][bj][m][0] * rs, v1 = b1 + acc[ai][bj][m][1] * rs;
                *(u32x4*)(XB + off) = pack8(v0, v1);
#pragma unroll
                for (int k = 0; k < 4; ++k) s2 += v0[k] * v0[k] + v1[k] * v1[k];
            }
            s2 = fq_reduce(s2); if (fq == 0) stat_add(ssq_out + row, s2);
        EPI_ROWS_END
    }
};
struct EpiResidB {
    static constexpr bool MID = false, AFTER = false, PREP = false, F8 = true, ACCINIT = true;
    bf16_t* XB; stat_t* ssq_out;
    __device__ __forceinline__ void init(f32x4 (&acc)[2][2][4][2], const Unit& u, int wr, int wc, int fr, int fq) const {
        const unsigned cb = (unsigned)(u.pn * 256 + wc * 32 + 8 * fq) * 2u;
#pragma unroll
        for (int ai = 0; ai < 2; ++ai)
#pragma unroll
            for (int m = 0; m < 4; ++m)
#pragma unroll
                for (int bj = 0; bj < 2; ++bj) {
                    const u32x4 w = *(const u32x4*)((const char*)XB + ((unsigned)(u.pm * 256 + ai * 128 + wr * 64 + m * 16 + fr) * (unsigned)(DM * 2) + cb + bj * 256u));
                    acc[ai][bj][m][0] = (f32x4){bf_lo(w.x), bf_hi(w.x), bf_lo(w.y), bf_hi(w.y)} * 2048.0f;
                    acc[ai][bj][m][1] = (f32x4){bf_lo(w.z), bf_hi(w.z), bf_lo(w.w), bf_hi(w.w)} * 2048.0f;
                }
    }
    __device__ __forceinline__ void operator()(const f32x4 (&acc)[2][2][4][2], const Unit& u, int wr, int wc, int fr, int fq) const {
        const unsigned cb = (unsigned)(u.pn * 256 + wc * 32 + 8 * fq) * 2u;
        EPI_ROWS_BEGIN
            float s2 = 0.f;
#pragma unroll
            for (int bj = 0; bj < 2; ++bj) {
                const f32x4 v0 = acc[ai][bj][m][0] * 0.00048828125f, v1 = acc[ai][bj][m][1] * 0.00048828125f;
                *(u32x4*)((char*)XB + ((unsigned)row * (unsigned)(DM * 2) + cb + bj * 256u)) = pack8(v0, v1);
#pragma unroll
                for (int k = 0; k < 4; ++k) s2 += v0[k] * v0[k] + v1[k] * v1[k];
            }
            s2 = fq_reduce(s2); if (fq == 0) stat_add(ssq_out + row, s2);
        EPI_ROWS_END
    }
};
struct EpiLog1 {
    static constexpr bool MID = false, AFTER = false, PREP = false;
    float* LOG1;
    __device__ __forceinline__ void operator()(const f32x4 (&acc)[2][2][4][2], const Unit& u, int wr, int wc, int fr, int fq) const {
        if (wc < 3) {
            float* base = LOG1 + wc * 32 + 8 * fq;
            EPI_ROWS_BEGIN
                *(f32x4*)(base + (size_t)row * 128) = acc[ai][0][m][0];
                *(f32x4*)(base + (size_t)row * 128 + 4) = acc[ai][0][m][1];
            EPI_ROWS_END
        }
    }
};
struct EpiRoute {
    static constexpr bool MID = false, AFTER = true, PREP = false, F8 = true;
    const float* LOG1; const stat_t* ssq_x2; const float* rbias; float* tokw; int* rowtok; int* toke; int* cnt;
    __device__ __forceinline__ void after(const f32x4 (&acc)[2][2][4][2], const Unit& u, int wr, int wc, int fr, int fq, LAS unsigned char* lds, int tid) const {
        LAS float* Lg = (LAS float*)lds;
        LAS int* hist = (LAS int*)(lds + 81920); LAS int* gbase = hist + 64;
        const int c0 = wc * 32 + 8 * fq;
        if (c0 < 72) {
            const f32x4 bb0 = *(const f32x4*)(rbias + c0), bb1 = *(const f32x4*)(rbias + c0 + 4);
            EPI_ROWS_BEGIN
                const float rs = rstd_of(stat_get(ssq_x2 + row), 1.0f / DM);
                const f32x4 l0 = *(const f32x4*)(LOG1 + (size_t)row * 128 + c0), l1 = *(const f32x4*)(LOG1 + (size_t)row * 128 + c0 + 4);
                *(LAS f32x4*)(Lg + rl * 72 + c0) = (l0 + acc[ai][0][m][0] * 0.00048828125f) * rs + bb0;
                *(LAS f32x4*)(Lg + rl * 72 + c0 + 4) = (l1 + acc[ai][0][m][1] * 0.00048828125f) * rs + bb1;
            EPI_ROWS_END
        }
        if (tid < 64) hist[tid] = 0;
        __syncthreads();
        int e0 = 0, e1 = 0, p0 = 0, p1 = 0; const int t = u.pm * 256 + tid;
        if (tid < 256) {
            const LAS float* lg = Lg + tid * 72;
            float g[8];
#pragma unroll
            for (int j = 0; j < 8; ++j) g[j] = lg[j];
            int grp = 0; float gm = g[0];
#pragma unroll
            for (int j = 1; j < 8; ++j) if (g[j] > gm) { gm = g[j]; grp = j; }
            float gs = 0.f;
#pragma unroll
            for (int j = 0; j < 8; ++j) gs += expf(g[j] - gm);
            const float p_grp = 1.0f / gs;
            float e[8];
#pragma unroll
            for (int j = 0; j < 8; ++j) e[j] = lg[8 + grp * 8 + j];
            int i0 = 0; float m0 = e[0];
#pragma unroll
            for (int j = 1; j < 8; ++j) if (e[j] > m0) { m0 = e[j]; i0 = j; }
            int i1 = -1; float m1 = -3.0e38f;
#pragma unroll
            for (int j = 0; j < 8; ++j) if (j != i0 && e[j] > m1) { m1 = e[j]; i1 = j; }
            const float r = expf(m1 - m0), w0 = 1.0f / (1.0f + r), w1 = r / (1.0f + r);
            e0 = grp * 8 + i0; e1 = grp * 8 + i1;
            tokw[t * 2] = p_grp * w0; tokw[t * 2 + 1] = p_grp * w1;
            p0 = __hip_atomic_fetch_add(hist + e0, 1, __ATOMIC_RELAXED, __HIP_MEMORY_SCOPE_WORKGROUP); p1 = __hip_atomic_fetch_add(hist + e1, 1, __ATOMIC_RELAXED, __HIP_MEMORY_SCOPE_WORKGROUP);
        }
        __syncthreads();
        if (tid < 64) { const int h = hist[tid]; gbase[tid] = h ? atomicAdd(cnt + tid, h) : 0; }
        __syncthreads();
        if (tid < 256) {
            const int q0 = gbase[e0] + p0, q1 = gbase[e1] + p1;
            rowtok[e0 * CAP + q0] = t * 2; rowtok[e1 * CAP + q1] = t * 2 + 1;
            toke[t * 2] = (e0 << 16) | q0; toke[t * 2 + 1] = (e1 << 16) | q1;
        }
    }
};
struct EpiGU {
    static constexpr bool MID = false, AFTER = false, PREP = true, F8 = true;
    unsigned char* H; const stat_t* ssq; const int* cnt; const int* rowtok;
    __device__ __forceinline__ void prep(const Unit& u, LAS float* tab, int tid) const {
        if (tid < 256) { const int idx = u.j * 256 + u.roff + tid; float rs = 0.f;
            if (idx < cnt[u.e] && (u.full || tid < 128)) { const int tok = rowtok[u.e * CAP + idx] >> 1; rs = rstd_of(stat_get(ssq + tok), 1.0f / DM); }
            tab[tid] = rs; }
    }
    __device__ __forceinline__ void operator()(const f32x4 (&acc)[2][2][4][2], const Unit& u, int wr, int wc, int fr, int fq, const LAS float* tab) const {
        const int pnl = u.pn & 3;
#pragma unroll
        for (int ai = 0; ai < 2; ++ai) {
            if (ai == 1 && !u.full) continue;
#pragma unroll
            for (int mp = 0; mp < 2; ++mp) {
                u32x2 pk[2];
#pragma unroll
                for (int ms = 0; ms < 2; ++ms) {
                    const int m = 2 * mp + ms;
                    const float rs = tab[ai * 128 + wr * 64 + m * 16 + fr] * 0.00390625f, rs8 = rs * 8.0f;
                    f32x4 h0, h1;
#pragma unroll
                    for (int k = 0; k < 4; ++k) { h0[k] = __builtin_amdgcn_fmed3f(silu_f(acc[ai][0][m][0][k] * rs) * (acc[ai][1][m][0][k] * rs8), -440.f, 440.f);
                                                  h1[k] = __builtin_amdgcn_fmed3f(silu_f(acc[ai][0][m][1][k] * rs) * (acc[ai][1][m][1][k] * rs8), -440.f, 440.f); }
                    pk[ms] = pack8_fp8(h0, h1);
                }
                const int row = u.pm * 256 + ai * 128 + wr * 64 + (2 * mp + (fq & 1)) * 16 + fr;
                const auto rx = __builtin_amdgcn_permlane16_swap(pk[0].x, pk[1].x, false, false), ry = __builtin_amdgcn_permlane16_swap(pk[0].y, pk[1].y, false, false);
                *(u32x4*)(H + (size_t)(row + u.roff) * DE + pnl * 128 + wc * 32 + 8 * (fq & ~1)) = (u32x4){rx[0], ry[0], rx[1], ry[1]};
            }
        }
    }
};
struct EpiDown {
    static constexpr bool MID = false, AFTER = false, PREP = false, F8 = true;
    unsigned char* YS;
    __device__ __forceinline__ void operator()(const f32x4 (&acc)[2][2][4][2], const Unit& u, int wr, int wc, int fr, int fq) const {
        const int pnl = u.pn & 7;
#pragma unroll
        for (int ai = 0; ai < 2; ++ai) {
            if (ai == 1 && !u.full) continue;
#pragma unroll
            for (int mp = 0; mp < 2; ++mp) {
                const int row = u.pm * 256 + ai * 128 + wr * 64 + (2 * mp + (fq & 1)) * 16 + fr;
#pragma unroll
                for (int bj = 0; bj < 2; ++bj) {
                    constexpr float SC = 0.0009765625f;
                    const u32x2 a = pack8_fp8(acc[ai][bj][2 * mp][0] * SC, acc[ai][bj][2 * mp][1] * SC), b = pack8_fp8(acc[ai][bj][2 * mp + 1][0] * SC, acc[ai][bj][2 * mp + 1][1] * SC);
                    const auto rx = __builtin_amdgcn_permlane16_swap(a.x, b.x, false, false), ry = __builtin_amdgcn_permlane16_swap(a.y, b.y, false, false);
                    *(u32x4*)(YS + (size_t)row * DM + pnl * 256 + bj * 128 + wc * 32 + 8 * (fq & ~1)) = (u32x4){rx[0], ry[0], rx[1], ry[1]};
                }
            }
        }
    }
};
struct MoeOrder {
    static constexpr bool LAZY_A = false, LINEAR_A = false;
    const LAS int* ts; const int* cnt; const int* rowtok; int npn, G, c; bool gather; bool split;
    __device__ bool next(int i, Unit& u) const {
        const int L = i * G + c, nfu = ts[80 + NEXP] * npn, nhu = ts[160 + NEXP] * npn;
        int Lf = -1, Lh = -1, full = 1, roff = 0;
        if (!split) { if (L < nfu) Lf = L; else if (L - nfu < nhu) { Lh = L - nfu; full = 0; } else return false; }
        else { const int F0 = (nfu / G) * G, R = nfu - F0;
            if (L < F0) Lf = L;
            else { const int Lq = L - F0; if (Lq < 2 * R) { Lf = F0 + (Lq >> 1); full = 0; roff = (Lq & 1) * 128; } else if (Lq - 2 * R < nhu) { Lh = Lq - 2 * R; full = 0; } else return false; } }
        const int lane = threadIdx.x & 63;
        int e, pn, j;
        if (Lf >= 0) {
            const unsigned long long mk = __ballot(Lf >= ts[80 + lane] * npn && Lf < ts[80 + lane + 1] * npn);
            e = __builtin_amdgcn_readfirstlane(__builtin_ctzll(mk));
            const int nfe = ts[80 + e + 1] - ts[80 + e], loc = Lf - ts[80 + e] * npn; pn = loc / nfe; j = loc - pn * nfe;
        } else {
            const int ih = Lh / npn; pn = Lh - ih * npn;
            const unsigned long long mk = __ballot(ih >= ts[160 + lane] && ih < ts[160 + lane + 1]);
            e = __builtin_amdgcn_readfirstlane(__builtin_ctzll(mk));
            j = ts[80 + e + 1] - ts[80 + e];
        }
        u.e = e; u.j = j; u.pm = ts[e] + j; u.pn = e * npn + pn; u.koff = 0u; u.full = full; u.roff = roff;
        return true;
    }
    __device__ __forceinline__ int arow(const Unit& u, int r) const {
        if (!gather) return u.pm * 256 + r;
        const int idx = u.j * 256 + u.roff + r;
        return (idx < cnt[u.e] && (u.full || r < 128)) ? (rowtok[u.e * CAP + idx] >> 1) : T;
    }
};

namespace att {
#define KSWZ(row, colB) ((row) * 256 + ((colB) ^ (((row) & 7) << 4)))
#define KRSWZ(row, colB) ((row) * 128 + ((colB) ^ (((row) & 7) << 4)))
#define SBAR() __builtin_amdgcn_sched_barrier(0)
constexpr int SHM_V = 64 * 128 * 2, SHM_K = 64 * 128 * 2, SHM_KR = 64 * 64 * 2;
constexpr int OFF_V = 0, OFF_K = 2 * SHM_V, OFF_KR = OFF_K + 2 * SHM_K, OFF_WS = OFF_KR + 2 * SHM_KR, OFF_QR = OFF_WS + 8 * 64 * 4, ATT_LDS = OFF_QR + 8 * 4096;
__device__ __forceinline__ int crow(int r, int hi) { return (r & 3) + 8 * (r >> 2) + 4 * hi; }
__device__ __forceinline__ int v_st(int k, int c) { const int kk = (k & ~0xC) | ((k & 4) << 1) | ((k & 8) >> 1); return ((kk >> 3) * 4 + (c >> 5)) * 512 + ((kk & 7) * 32 + (c & 31)) * 2; }
__device__ __forceinline__ int v_rd_base(int lane) { return ((lane & 3) << 3) | (((lane >> 2) & 3) << 6) | (((lane >> 4) & 1) << 5) | (((lane >> 5) & 1) << 8); }
constexpr int v_rd_off(int d0, int ks, int half) { return d0 * 512 + ks * 4096 + half * 2048; }
template <int OFF> __device__ __forceinline__ s16x4 tr_read(int vb) { s16x4 r; asm volatile("ds_read_b64_tr_b16 %0, %1 offset:%2" : "=&v"(r) : "v"(vb), "i"(OFF) : "memory"); return r; }
template <int D0> __device__ __forceinline__ void pv_one(f32x16& od, int vb, bf16x8 pa0, bf16x8 pa1, bf16x8 pa2, bf16x8 pa3) {
    const s16x4 l0 = tr_read<v_rd_off(D0, 0, 0)>(vb), h0 = tr_read<v_rd_off(D0, 0, 1)>(vb), l1 = tr_read<v_rd_off(D0, 1, 0)>(vb), h1 = tr_read<v_rd_off(D0, 1, 1)>(vb);
    const s16x4 l2 = tr_read<v_rd_off(D0, 2, 0)>(vb), h2 = tr_read<v_rd_off(D0, 2, 1)>(vb), l3 = tr_read<v_rd_off(D0, 3, 0)>(vb), h3 = tr_read<v_rd_off(D0, 3, 1)>(vb);
    asm volatile("s_waitcnt lgkmcnt(0)" ::: "memory"); SBAR();
#define PK(L, Hh) (bf16x8){L[0], L[1], L[2], L[3], Hh[0], Hh[1], Hh[2], Hh[3]}
    od = __builtin_amdgcn_mfma_f32_32x32x16_bf16(pa0, PK(l0, h0), od, 0, 0, 0);
    od = __builtin_amdgcn_mfma_f32_32x32x16_bf16(pa1, PK(l1, h1), od, 0, 0, 0);
    od = __builtin_amdgcn_mfma_f32_32x32x16_bf16(pa2, PK(l2, h2), od, 0, 0, 0);
    od = __builtin_amdgcn_mfma_f32_32x32x16_bf16(pa3, PK(l3, h3), od, 0, 0, 0);
#undef PK
}
__device__ __forceinline__ void pv_d0(f32x16* o, int vb, bf16x8 pa0, bf16x8 pa1, bf16x8 pa2, bf16x8 pa3) {
    pv_one<0>(o[0], vb, pa0, pa1, pa2, pa3); pv_one<1>(o[1], vb, pa0, pa1, pa2, pa3); pv_one<2>(o[2], vb, pa0, pa1, pa2, pa3); pv_one<3>(o[3], vb, pa0, pa1, pa2, pa3);
}
template <int DR> struct Sc { static constexpr float SCALE = DR ? 0.07216878364870322f : 0.08838834764831845f; };
template <int DR> __device__ __forceinline__ void partialSM(f32x16& p0, f32x16& p1, float& m_reg, float& mn, float& alpha) {
    constexpr float SCALE = Sc<DR>::SCALE, C = SCALE * 1.4426950408889634f, THR = 8.f;
    float pmax = p0[0];
#pragma unroll
    for (int r = 1; r < 16; ++r) pmax = fmaxf(pmax, p0[r]);
#pragma unroll
    for (int r = 0; r < 16; ++r) pmax = fmaxf(pmax, p1[r]);
    { auto rr = __builtin_amdgcn_permlane32_swap(__float_as_uint(pmax), __float_as_uint(pmax), false, false); pmax = fmaxf(__uint_as_float(rr[0]), __uint_as_float(rr[1])); }
    if (__builtin_expect(__all(pmax - m_reg <= THR / SCALE), 1)) { mn = m_reg; alpha = 1.f; }
    else { mn = fmaxf(m_reg, pmax); alpha = __builtin_amdgcn_exp2f((m_reg - mn) * C); m_reg = mn; }
    const float mnC = -mn * C;
#pragma unroll
    for (int r = 0; r < 16; ++r) p0[r] = fmaf(p0[r], C, mnC);
#pragma unroll
    for (int r = 0; r < 16; ++r) p1[r] = fmaf(p1[r], C, mnC);
#pragma unroll
    for (int r = 0; r < 16; ++r) p0[r] = __builtin_amdgcn_exp2f(p0[r]);
}
__device__ __forceinline__ void finishSM(f32x16& p0, f32x16& p1, float alpha, float& l_reg, bf16x8& pa0, bf16x8& pa1, bf16x8& pa2, bf16x8& pa3) {
#pragma unroll
    for (int r = 0; r < 16; ++r) p1[r] = __builtin_amdgcn_exp2f(p1[r]);
    float ps = 0;
#pragma unroll
    for (int r = 0; r < 16; ++r) ps += p0[r];
#pragma unroll
    for (int r = 0; r < 16; ++r) ps += p1[r];
    { auto rr = __builtin_amdgcn_permlane32_swap(__float_as_uint(ps), __float_as_uint(ps), false, false); ps = __uint_as_float(rr[0]) + __uint_as_float(rr[1]); }
    l_reg = l_reg * alpha + ps;
#define PK4(P, BASE, OUT) do { unsigned a0 = cvt_pk_bf16(P[BASE + 0], P[BASE + 1]), a1 = cvt_pk_bf16(P[BASE + 2], P[BASE + 3]);   \
    unsigned b0 = cvt_pk_bf16(P[BASE + 4], P[BASE + 5]), b1 = cvt_pk_bf16(P[BASE + 6], P[BASE + 7]);                              \
    auto r0 = __builtin_amdgcn_permlane32_swap(a0, b0, false, false); auto r1 = __builtin_amdgcn_permlane32_swap(a1, b1, false, false); \
    u32x4 w = {r0[0], r1[0], r0[1], r1[1]}; OUT = *reinterpret_cast<bf16x8*>(&w); } while (0)
    PK4(p0, 0, pa0); PK4(p0, 8, pa1); PK4(p1, 0, pa2); PK4(p1, 8, pa3);
#undef PK4
}
template <int DR> __device__ __forceinline__ void qkt(f32x16& p0, f32x16& p1, const char* Ks, const char* Krs, const bf16x8* qr, const char* qrl, int r32, int hi) {
    p0 = f32x16{}; p1 = f32x16{};
#pragma unroll
    for (int d0 = 0; d0 < 8; ++d0) { const int cb = (d0 * 16 + hi * 8) * 2;
        const bf16x8 b0 = *reinterpret_cast<const bf16x8*>(Ks + KSWZ(r32, cb));
        const bf16x8 b1 = *reinterpret_cast<const bf16x8*>(Ks + KSWZ(32 + r32, cb));
        p0 = __builtin_amdgcn_mfma_f32_32x32x16_bf16(b0, qr[d0], p0, 0, 0, 0);
        p1 = __builtin_amdgcn_mfma_f32_32x32x16_bf16(b1, qr[d0], p1, 0, 0, 0); }
    if (DR) {
#pragma unroll
        for (int d0 = 0; d0 < DR / 16; ++d0) { const int cb = (d0 * 16 + hi * 8) * 2;
            const bf16x8 b0 = *reinterpret_cast<const bf16x8*>(Krs + KRSWZ(r32, cb));
            const bf16x8 b1 = *reinterpret_cast<const bf16x8*>(Krs + KRSWZ(32 + r32, cb));
            const bf16x8 qf = *reinterpret_cast<const bf16x8*>(qrl + d0 * 1024);
            p0 = __builtin_amdgcn_mfma_f32_32x32x16_bf16(b0, qf, p0, 0, 0, 0);
            p1 = __builtin_amdgcn_mfma_f32_32x32x16_bf16(b1, qf, p1, 0, 0, 0); }
    }
}
__device__ __forceinline__ void cmask(f32x16& p0, f32x16& p1, int kv0, int qrel, int hi) {
#pragma unroll
    for (int r = 0; r < 16; ++r) { const int kv = kv0 + (r & 3) + 8 * (r >> 2) + 4 * hi; if (kv > qrel) p0[r] = -1e30f; if (kv + 32 > qrel) p1[r] = -1e30f; }
}
template <int DR, bool CAUSAL, int LDQ, int LDK, int LDO, bool O8 = false>
__device__ __forceinline__ void attn_unit(const bf16_t* __restrict__ Qb, const bf16_t* __restrict__ Kn, const bf16_t* __restrict__ Vh, const bf16_t* __restrict__ Kr,
                                          bf16_t* __restrict__ Ob, const int NT, stat_t* ssq, char* lds) {
    int tid_ = threadIdx.x; asm volatile("" : "+v"(tid_));
    const int tid = tid_, wid = tid >> 6, lane = tid & 63, r32 = lane & 31, hi = lane >> 5;
    char* V_lds = lds + OFF_V; char* K_lds = lds + OFF_K; char* KR_lds = lds + OFF_KR;
    float* ws = (float*)(lds + OFF_WS) + wid * 64; float* li_l = ws; float* al_l = ws + 32;
    float m_reg = -1e30f, l_reg = 0; f32x16 o[4] = {}; bf16x8 qr[8];
    const char* qrl = lds + OFF_QR + wid * 4096 + lane * 16;
    const bf16_t* Qw = Qb + (long)(wid * 32 + r32) * LDQ + hi * 8;
#pragma unroll
    for (int d0 = 0; d0 < 8; ++d0) qr[d0] = *reinterpret_cast<const bf16x8*>(Qw + d0 * 16);
    if (DR) {
#pragma unroll
        for (int d0 = 0; d0 < DR / 16; ++d0) *(bf16x8*)(lds + OFF_QR + wid * 4096 + lane * 16 + d0 * 1024) = *reinterpret_cast<const bf16x8*>(Qw + 128 + d0 * 16);
    }
    const int sr = tid >> 4, sc = (tid & 15) * 8, vst0 = v_st(sr, sc), vst1 = v_st(32 + sr, sc);
    const int krr = tid >> 3, krc = (tid & 7) * 8;
    const int vb0 = (int)(uintptr_t)V_lds + v_rd_base(lane);
    bf16x8 vs0, vs1, ks0, ks1, krs;
    const unsigned vo0 = (unsigned)((sr * LDK + sc) * 2), vo1 = vo0 + 32u * LDK * 2u, kro = (unsigned)((krr * ROPE + krc) * 2);
#define SLOAD(k0) do { const char* vt_ = (const char*)Vh + (size_t)(k0) * (LDK * 2); const char* kt_ = (const char*)Kn + (size_t)(k0) * (LDK * 2); \
    vs0 = *reinterpret_cast<const bf16x8*>(vt_ + vo0); vs1 = *reinterpret_cast<const bf16x8*>(vt_ + vo1); \
    ks0 = *reinterpret_cast<const bf16x8*>(kt_ + vo0); ks1 = *reinterpret_cast<const bf16x8*>(kt_ + vo1); \
    if (DR) krs = *reinterpret_cast<const bf16x8*>((const char*)Kr + (size_t)(k0) * (ROPE * 2) + kro); } while (0)
#define SWRITE(b) do { *(bf16x8*)(V_lds + (b) * SHM_V + vst0) = vs0; *(bf16x8*)(V_lds + (b) * SHM_V + vst1) = vs1; const int kc = sc * 2; \
    *(bf16x8*)(K_lds + (b) * SHM_K + KSWZ(sr, kc)) = ks0; *(bf16x8*)(K_lds + (b) * SHM_K + KSWZ(32 + sr, kc)) = ks1; \
    if (DR) *(bf16x8*)(KR_lds + (b) * SHM_KR + KRSWZ(krr, krc * 2)) = krs; } while (0)
#define RESC(a) do { if (__any((a) < 1.f)) { if (hi == 0) al_l[r32] = (a); asm volatile("s_waitcnt lgkmcnt(0)" ::: "memory"); \
    _Pragma("unroll") for (int d = 0; d < 4; ++d) _Pragma("unroll") for (int r = 0; r < 16; ++r) o[d][r] *= al_l[crow(r, hi)]; } } while (0)
#define CM(P0, P1, jt) do { if (CAUSAL && (jt) >= NT - 4) cmask(P0, P1, ((jt) - (NT - 4)) * 64, wid * 32 + r32, hi); } while (0)
    f32x16 pA0, pA1, pB0, pB1; float mnA, mnB, alA, alB; bf16x8 pa0, pa1, pa2, pa3;
    SLOAD(0); asm volatile("s_waitcnt vmcnt(0)" ::: "memory"); SWRITE(0); __syncthreads();
    qkt<DR>(pA0, pA1, K_lds, KR_lds, qr, qrl, r32, hi); CM(pA0, pA1, 0); partialSM<DR>(pA0, pA1, m_reg, mnA, alA);
    SLOAD(64);
    asm volatile("s_waitcnt vmcnt(0)" ::: "memory"); SWRITE(1); __syncthreads();
    for (int j = 1; j + 1 < NT; j += 2) {
        SBAR(); qkt<DR>(pB0, pB1, K_lds + SHM_K, KR_lds + SHM_KR, qr, qrl, r32, hi); CM(pB0, pB1, j);
        finishSM(pA0, pA1, alA, l_reg, pa0, pa1, pa2, pa3); SBAR();
        SLOAD((j + 1) * 64); SBAR();
        pv_d0(o, vb0, pa0, pa1, pa2, pa3); partialSM<DR>(pB0, pB1, m_reg, mnB, alB);
        __syncthreads(); asm volatile("s_waitcnt vmcnt(0)" ::: "memory"); SWRITE(0);
        RESC(alB); __syncthreads();
        SBAR(); qkt<DR>(pA0, pA1, K_lds, KR_lds, qr, qrl, r32, hi); CM(pA0, pA1, j + 1);
        finishSM(pB0, pB1, alB, l_reg, pa0, pa1, pa2, pa3); SBAR();
        SLOAD((j + 2) * 64); SBAR();
        pv_d0(o, vb0 + SHM_V, pa0, pa1, pa2, pa3); partialSM<DR>(pA0, pA1, m_reg, mnA, alA);
        __syncthreads(); asm volatile("s_waitcnt vmcnt(0)" ::: "memory"); SWRITE(1);
        RESC(alA); __syncthreads();
    }
    SBAR(); qkt<DR>(pB0, pB1, K_lds + SHM_K, KR_lds + SHM_KR, qr, qrl, r32, hi); CM(pB0, pB1, NT - 1);
    finishSM(pA0, pA1, alA, l_reg, pa0, pa1, pa2, pa3); SBAR();
    pv_d0(o, vb0, pa0, pa1, pa2, pa3); partialSM<DR>(pB0, pB1, m_reg, mnB, alB);
    __syncthreads(); RESC(alB);
    finishSM(pB0, pB1, alB, l_reg, pa0, pa1, pa2, pa3); SBAR();
    pv_d0(o, vb0 + SHM_V, pa0, pa1, pa2, pa3);
    if (hi == 0) li_l[r32] = l_reg; asm volatile("s_waitcnt lgkmcnt(0)" ::: "memory");
    bf16_t* Op = O8 ? (bf16_t*)((unsigned char*)Ob + (long)(wid * 32 + 4 * hi) * LDO + r32) : Ob + (long)(wid * 32 + 4 * hi) * LDO + r32; stat_t* sp = ssq + wid * 32 + 4 * hi;
    asm volatile("" : "+v"(Op), "+v"(sp));
#pragma unroll
    for (int r = 0; r < 16; ++r) { const int orl = (r & 3) + 8 * (r >> 2); const float rli = __builtin_amdgcn_rcpf(li_l[orl + 4 * hi]); float s2 = 0.f;
#pragma unroll
        for (int d0 = 0; d0 < 4; ++d0) { const float v = o[d0][r] * rli; s2 += v * v;
            if constexpr (O8) ((GAS unsigned char*)Op)[orl * LDO + d0 * 32] = (unsigned char)(__builtin_amdgcn_cvt_pk_fp8_f32(v * 16.0f, 0.f, 0, false) & 0xff);
            else ((GAS bf16_t*)Op)[orl * LDO + d0 * 32] = (bf16_t)(cvt_pk_bf16(v, 0.f) & 0xffffu); }
        if (ssq) {
#pragma unroll
            for (int of = 1; of < 32; of <<= 1) s2 += __shfl_xor(s2, of);
            if (r32 == 0) (void)__hip_atomic_fetch_add((GAS stat_t*)sp + orl, (stat_t)(long long)(s2 * 4294967296.0f), __ATOMIC_RELAXED, __HIP_MEMORY_SCOPE_AGENT);
        }
    }
    __syncthreads();
#undef SLOAD
#undef SWRITE
#undef RESC
#undef CM
}
#undef SBAR
}

struct TrGeo { int nblk, per, K, N; };
__device__ __forceinline__ void tr_load(const float* W, const TrGeo& G, int it, int lane, f32x4 (&v)[16]) {
    const int e = it / G.per, r = it - e * G.per, kb = r / G.nblk, nb = r - kb * G.nblk;
    const float* src = W + (size_t)e * G.K * G.N + (size_t)(64 * kb + (lane >> 4)) * G.N + 64 * nb + (lane & 15) * 4;
#pragma unroll
    for (int i = 0; i < 16; ++i) v[i] = *(const f32x4*)(src + (size_t)(4 * i) * G.N);
}
template <class RowMap>
__device__ __forceinline__ void tr_store(const TrGeo& G, int it, int lane, const f32x4 (&v)[16], const float* gain, bf16_t* WT, const RowMap& rm, LAS float* scr, int ldt) {
    const int e = it / G.per, r = it - e * G.per, kb = r / G.nblk, nb = r - kb * G.nblk, k0 = 64 * kb, n0 = 64 * nb;
    const int lk = lane >> 4, ln4 = (lane & 15) * 4, c = lane >> 3, ns = lane & 7;
    f32x4 g0 = {1.f, 1.f, 1.f, 1.f}, g1 = {1.f, 1.f, 1.f, 1.f};
    if (gain) { g0 = *(const f32x4*)(gain + k0 + 8 * c); g1 = *(const f32x4*)(gain + k0 + 8 * c + 4); }
#pragma unroll
    for (int i = 0; i < 16; ++i) { LAS float* d = scr + (4 * i + lk) * 65 + ln4; d[0] = v[i].x; d[1] = v[i].y; d[2] = v[i].z; d[3] = v[i].w; }
    asm volatile("s_waitcnt lgkmcnt(0)" ::: "memory");
#pragma unroll
    for (int j = 0; j < 8; ++j) { const int n = ns + 8 * j; const LAS float* q = scr + (8 * c) * 65 + n;
        u32x4 o; o.x = cvt_pk_bf16(q[0 * 65] * g0.x, q[1 * 65] * g0.y); o.y = cvt_pk_bf16(q[2 * 65] * g0.z, q[3 * 65] * g0.w);
        o.z = cvt_pk_bf16(q[4 * 65] * g1.x, q[5 * 65] * g1.y); o.w = cvt_pk_bf16(q[6 * 65] * g1.z, q[7 * 65] * g1.w);
        *(u32x4*)(WT + (size_t)rm(e, n0 + n) * ldt + k0 + 8 * c) = o; }
    asm volatile("s_waitcnt lgkmcnt(0)" ::: "memory");
}
template <class RowMap>
__device__ __forceinline__ void tr_store8(const TrGeo& G, int it, int lane, const f32x4 (&v)[16], const float* gain, float scale, unsigned char* WT, const RowMap& rm, LAS float* scr, int ldt) {
    const int e = it / G.per, r = it - e * G.per, kb = r / G.nblk, nb = r - kb * G.nblk, k0 = 64 * kb, n0 = 64 * nb;
    const int lk = lane >> 4, ln4 = (lane & 15) * 4, c = lane >> 4, ns = lane & 15;
    f32x4 g[4];
#pragma unroll
    for (int q = 0; q < 4; ++q) { g[q] = (f32x4){scale, scale, scale, scale}; if (gain) g[q] = g[q] * *(const f32x4*)(gain + k0 + 16 * c + 4 * q); }
#pragma unroll
    for (int i = 0; i < 16; ++i) { LAS float* d = scr + (4 * i + lk) * 65 + ln4; d[0] = v[i].x; d[1] = v[i].y; d[2] = v[i].z; d[3] = v[i].w; }
    asm volatile("s_waitcnt lgkmcnt(0)" ::: "memory");
#pragma unroll
    for (int j = 0; j < 4; ++j) { const int n = ns + 16 * j; const LAS float* q = scr + (16 * c) * 65 + n;
        f32x4 a[4];
#pragma unroll
        for (int t = 0; t < 4; ++t) { a[t].x = q[(4 * t) * 65] * g[t].x; a[t].y = q[(4 * t + 1) * 65] * g[t].y; a[t].z = q[(4 * t + 2) * 65] * g[t].z; a[t].w = q[(4 * t + 3) * 65] * g[t].w; }
        const u32x2 lo = pack8_fp8(a[0], a[1]), hi = pack8_fp8(a[2], a[3]);
        *(u32x4*)(WT + (size_t)rm(e, n0 + n) * ldt + k0 + 16 * c) = (u32x4){lo.x, lo.y, hi.x, hi.y}; }
    asm volatile("s_waitcnt lgkmcnt(0)" ::: "memory");
}
template <bool F8 = false, class RowMap>
__device__ __forceinline__ void tr_job(const float* W, int nmat, int K, int N, const float* gain, bf16_t* WT, const RowMap rm, LAS float* scr, int gw, int ngw, int lane, int ldt = 0, int j0 = 0, int j1 = 1 << 20, float f8scale = 1.f) {
    if (ldt == 0) ldt = K;
    TrGeo G; G.nblk = N / 64; G.per = G.nblk * (K / 64); G.K = K; G.N = N;
    int total = nmat * G.per;
    { const long lim = (long)gw + (long)j1 * ngw; if (lim < total) total = (int)lim; }
    f32x4 va[16], vb[16];
    int it = gw + j0 * ngw;
    if (it >= total) return;
    tr_load(W, G, it, lane, va);
    asm volatile("" ::: "memory");
    for (;;) {
        const int it2 = it + ngw;
        tr_load(W, G, it2 < total ? it2 : it, lane, vb);
        asm volatile("" ::: "memory");
        if constexpr (F8) tr_store8(G, it, lane, va, gain, f8scale, (unsigned char*)WT, rm, scr, ldt); else tr_store(G, it, lane, va, gain, WT, rm, scr, ldt);
        asm volatile("" ::: "memory");
        if (it2 >= total) break;
        const int it3 = it2 + ngw;
        tr_load(W, G, it3 < total ? it3 : it2, lane, va);
        asm volatile("" ::: "memory");
        if constexpr (F8) tr_store8(G, it2, lane, vb, gain, f8scale, (unsigned char*)WT, rm, scr, ldt); else tr_store(G, it2, lane, vb, gain, WT, rm, scr, ldt);
        asm volatile("" ::: "memory");
        if (it3 >= total) break;
        it = it3;
    }
}
struct RmId { int off; __device__ int operator()(int, int n) const { return off + n; } };
struct RmWin { __device__ int operator()(int, int n) const { if (n < 2816) return n; const int j = n - 2816; return 2816 + (j < 32 ? 2 * j : 2 * (j - 32) + 1); } };
struct RmUq { __device__ int operator()(int, int n) const { const int h = n / 192, dd = n - h * 192; if (dd < 128) return n; const int j = dd - 128; return h * 192 + 128 + (j < 32 ? 2 * j : 2 * (j - 32) + 1); } };
struct RmGate { int up; __device__ int operator()(int e, int n) const { return e * 1024 + (n >> 7) * 256 + up * 128 + (n & 127); } };
struct RmDown { __device__ int operator()(int e, int n) const { return e * 2048 + n; } };

__device__ __forceinline__ void rms_row_load(const float* xrow, int lane, f32x4 (&v)[8]) {
#pragma unroll
    for (int j = 0; j < 8; ++j) v[j] = *(const f32x4*)(xrow + 4 * lane + 256 * j);
}
__device__ __forceinline__ void rms_row_finish(const f32x4 (&v)[8], bf16_t* orow, int lane, float* rstd_out) {
    float s = 0.f;
#pragma unroll
    for (int j = 0; j < 8; ++j) s += (v[j].x * v[j].x + v[j].y * v[j].y) + (v[j].z * v[j].z + v[j].w * v[j].w);
    const float rs = 1.0f / sqrtf(wave_sum(s) * (1.0f / DM) + EPS);
    if (rstd_out && lane == 0) *rstd_out = rs;
#pragma unroll
    for (int j = 0; j < 8; ++j) { u32x2 w; w.x = cvt_pk_bf16(v[j].x * rs, v[j].y * rs); w.y = cvt_pk_bf16(v[j].z * rs, v[j].w * rs); *(u32x2*)(orow + 4 * lane + 256 * j) = w; }
}
__device__ __forceinline__ void rms_row_bf16(const float* xrow, const float* g, bf16_t* orow, int lane, float* rstd_out = nullptr) {
    f32x4 v[8]; float s = 0.f;
#pragma unroll
    for (int j = 0; j < 8; ++j) { v[j] = *(const f32x4*)(xrow + 4 * lane + 256 * j); s += (v[j].x * v[j].x + v[j].y * v[j].y) + (v[j].z * v[j].z + v[j].w * v[j].w); }
    const float rs = 1.0f / sqrtf(wave_sum(s) * (1.0f / DM) + EPS);
    if (rstd_out && lane == 0) *rstd_out = rs;
#pragma unroll
    for (int j = 0; j < 8; ++j) { const f32x4 gg = g ? *(const f32x4*)(g + 4 * lane + 256 * j) : (f32x4){1.f, 1.f, 1.f, 1.f}; u32x2 w; w.x = cvt_pk_bf16(v[j].x * rs * gg.x, v[j].y * rs * gg.y); w.y = cvt_pk_bf16(v[j].z * rs * gg.z, v[j].w * rs * gg.w);
        *(u32x2*)(orow + 4 * lane + 256 * j) = w; }
}

constexpr int XC_PER = 32768, XC_ITEMS = 3 * XC_PER;
struct XcPtrs { const float *w0, *w1, *w2; unsigned char *gu, *wd; };
__device__ __forceinline__ void xd_issue(const XcPtrs& F, int g, int lane, LAS unsigned char* slot) {
    const int job = g >> 15, it = g & (XC_PER - 1), e = it >> 9, r = it & 511;
    const int N = job < 2 ? DE : DM, kb = job < 2 ? (r >> 4) : (r >> 6), nb = job < 2 ? (r & 15) : (r & 63);
    const float* W = job == 0 ? F.w0 : (job == 1 ? F.w1 : F.w2);
    const char* base = (const char*)(W + (size_t)e * DM * DE + (size_t)(64 * kb) * N + 32 * nb);
    const unsigned rowB = (unsigned)N * 4u;
    const unsigned o0 = (unsigned)(lane >> 3) * rowB + (unsigned)(lane & 7) * 16u, o1 = (unsigned)(lane >> 3) * rowB + (unsigned)((lane & 7) ^ 4) * 16u;
#pragma unroll
    for (int i = 0; i < 8; ++i) {
        const char* bi = base + (size_t)(8 * i) * rowB; unsigned o = ((i >> 1) & 1) ? o1 : o0;
        asm volatile("" : "+s"(bi), "+v"(o));
        __builtin_amdgcn_global_load_lds((const unsigned*)(bi + o), (LAS unsigned*)(slot + i * 1024), 16, 0, 0);
    }
}
__device__ __forceinline__ void xd_process(const XcPtrs& F, int g, int lane, const LAS unsigned char* slot) {
    const int job = g >> 15, it = g & (XC_PER - 1), e = it >> 9, r = it & 511;
    const int kb = job < 2 ? (r >> 4) : (r >> 6), nb = job < 2 ? (r & 15) : (r & 63), k0 = 64 * kb, n0 = 32 * nb;
    const int ldt = job < 2 ? DM : DE;
    const float scale = job < 2 ? 256.f : 128.f;
    unsigned char* WT = job < 2 ? F.gu : F.wd;
    const int c = lane >> 4, ns = lane & 15;
#pragma unroll
    for (int j = 0; j < 2; ++j) { const int n = ns + 16 * j, nn = n0 + n;
        const LAS float* q = (const LAS float*)(slot + (16 * c) * 128 + (((n >> 2) ^ ((c & 1) << 2)) * 16) + (n & 3) * 4);
        f32x4 a[4];
#pragma unroll
        for (int t = 0; t < 4; ++t) { a[t].x = q[(4 * t) * 32] * scale; a[t].y = q[(4 * t + 1) * 32] * scale; a[t].z = q[(4 * t + 2) * 32] * scale; a[t].w = q[(4 * t + 3) * 32] * scale; }
        const u32x2 lo = pack8_fp8(a[0], a[1]), hi = pack8_fp8(a[2], a[3]);
        const int row = job < 2 ? e * 1024 + (nn >> 7) * 256 + job * 128 + (nn & 127) : e * 2048 + nn;
        *(u32x4*)(WT + (size_t)row * ldt + k0 + 16 * c) = (u32x4){lo.x, lo.y, hi.x, hi.y}; }
}
__device__ __forceinline__ void expert_convert(Frame& FR, int ja, int jb) {
    int t_ = (int)threadIdx.x; asm volatile("" : "+v"(t_));
    const int lane = t_ & 63, wave = __builtin_amdgcn_readfirstlane(t_ >> 6);
    LAS unsigned char* s0 = FR.lds + wave * 16384; LAS unsigned char* s1 = s0 + 8192;
    const int gw = FR.vcu * 8 + wave, ngw = FR.G * 8;
    const XcPtrs F{FR.in[26], FR.in[27], FR.in[28], FR.ws + WS_WGU, FR.ws + WS_WD};
    int total = XC_ITEMS;
    { const long lim = (long)gw + (long)jb * ngw; if (lim < total) total = (int)lim; }
    int g0 = gw + ja * ngw;
    if (g0 >= total) return;
#define XC_CL(x) ((x) < total ? (x) : g0)
    xd_issue(F, g0, lane, s0); xd_issue(F, XC_CL(g0 + ngw), lane, s1);
    asm volatile("s_waitcnt vmcnt(8)" ::: "memory");
    for (;;) {
        xd_process(F, g0, lane, s0);
        asm volatile("s_waitcnt lgkmcnt(0)" ::: "memory");
        xd_issue(F, XC_CL(g0 + 2 * ngw), lane, s0);
        if (g0 + ngw >= total) break;
        asm volatile("s_waitcnt vmcnt(10)" ::: "memory");
        xd_process(F, g0 + ngw, lane, s1);
        asm volatile("s_waitcnt lgkmcnt(0)" ::: "memory");
        xd_issue(F, XC_CL(g0 + 3 * ngw), lane, s1);
        if (g0 + 2 * ngw >= total) break;
        asm volatile("s_waitcnt vmcnt(10)" ::: "memory");
        g0 += 2 * ngw;
    }
    asm volatile("s_waitcnt vmcnt(0)" ::: "memory");
#undef XC_CL
}
__device__ __forceinline__ void p0_prologue(Frame& F) {
    LAS float* scr = (LAS float*)(F.lds + F.wave * 16640);
    const int gw = F.vcu * 8 + F.wave, ngw = F.G * 8, lane = F.lane;
    const int gt = gw * 64 + lane, ngt = ngw * 64;
#define ROT(r) ((gw + ngw - ((r) % ngw)) % ngw)
    tr_job(F.in[3], 1, DM, INW, F.in[2], WSP(bf16_t, WS_WIN), RmWin{}, scr, ROT(0), ngw, lane);
    tr_job(F.in[9], 1, QL, NQ, F.in[8], WSP(bf16_t, WS_WUQ), RmUq{}, scr, ROT(1440), ngw, lane);
    tr_job(F.in[11], 1, KVL, NKV, F.in[10], WSP(bf16_t, WS_WUKV), RmId{0}, scr, ROT(1632), ngw, lane);
    tr_job(F.in[14], 1, GW, DM, F.in[12], WSP(bf16_t, WS_WOA), RmId{0}, scr, ROT(1760), ngw, lane, DM);
    tr_job(F.in[14] + (size_t)GW * DM, 1, GW, DM, F.in[13], WSP(bf16_t, WS_WOA) + GW, RmId{0}, scr, ROT(2272), ngw, lane, DM);
    tr_job(F.in[17], 1, DM, 512, F.in[15], WSP(bf16_t, WS_WMQ), RmId{0}, scr, ROT(2784), ngw, lane);
    tr_job(F.in[18], 1, DM, 512, nullptr, WSP(bf16_t, WS_WMKV), RmId{0}, scr, ROT(3040), ngw, lane);
    tr_job(F.in[19], 1, DM, 512, nullptr, WSP(bf16_t, WS_WMKV), RmId{512}, scr, ROT(3296), ngw, lane);
    tr_job<true>(F.in[20], 1, 512, DM, nullptr, WSP(bf16_t, WS_WMO), RmId{0}, scr, ROT(3552), ngw, lane, 0, 0, 1 << 20, 128.f);
    tr_job(F.in[24], 1, DM, 64, F.in[21], WSP(bf16_t, WS_WR), RmId{8}, scr, ROT(3808), ngw, lane);
#undef ROT
    for (int i = gt; i < DM * 8; i += ngt) { const int k = i >> 3, n = i & 7; WSP(bf16_t, WS_WR)[(size_t)n * DM + k] = (bf16_t)(cvt_pk_bf16(F.in[22][i] * F.in[21][k], 0.f) & 0xffffu); }
    for (int i = gt; i < (INWP - INW) * DM / 8; i += ngt) ((u32x4*)(WSP(bf16_t, WS_WIN) + (size_t)INW * DM))[i] = (u32x4){0u, 0u, 0u, 0u};
    for (int i = gt; i < (256 - 72) * DM / 8; i += ngt) ((u32x4*)(WSP(bf16_t, WS_WR) + (size_t)72 * DM))[i] = (u32x4){0u, 0u, 0u, 0u};
    for (int i = gt; i < DM / 8; i += ngt) ((u32x4*)(WSP(bf16_t, WS_HB) + (size_t)T * DM))[i] = (u32x4){0u, 0u, 0u, 0u};
    for (int i = gt; i < DM / 16; i += ngt) ((u32x4*)(WSP(unsigned char, WS_X8) + (size_t)T * DM))[i] = (u32x4){0u, 0u, 0u, 0u};
    for (int i = gt; i < 8 * 128 * 128; i += ngt) { const int sI = i & 127, tI = (i >> 7) & 127; WSP(bf16_t, WS_WSPB)[i] = (sI <= tI) ? (bf16_t)(cvt_pk_bf16(F.in[6][i], 0.f) & 0xffffu) : (bf16_t)0; }
    for (int i = gt; i < 512 * DM / 8; i += ngt) { const f32x4 a = *(const f32x4*)(F.in[20] + (size_t)i * 8), b = *(const f32x4*)(F.in[20] + (size_t)i * 8 + 4); ((u32x4*)WSP(bf16_t, WS_WMOB))[i] = pack8(a, b); }
    for (int i = gt; i < 256; i += ngt) WSP(float, WS_RB)[i] = i < 8 ? F.in[23][i] : (i < 72 ? F.in[25][i - 8] : 0.f);
    for (int i = gt; i < SEQ * 32; i += ngt) { const int pos = i >> 5, k = i & 31; const float invf = (float)pow(10000.0, -(double)(2 * k) / 64.0); const float ang = (float)pos * invf;
        WSP(float, WS_COS)[i] = (float)cos((double)ang); WSP(float, WS_SIN)[i] = (float)sin((double)ang); }
    {
        f32x4 va[8], vb[8];
        int r = gw;
        if (r < T) {
            rms_row_load(F.in[0] + (size_t)r * DM, lane, va); asm volatile("" ::: "memory");
            for (;;) {
                const int r1 = r + ngw, r2 = r1 + ngw;
                rms_row_load(F.in[0] + (size_t)(r1 < T ? r1 : r) * DM, lane, vb); asm volatile("" ::: "memory");
                rms_row_finish(va, WSP(bf16_t, WS_HB) + (size_t)r * DM, lane, WSP(float, WS_RSTDX) + r); asm volatile("" ::: "memory");
                if (r1 >= T) break;
                rms_row_load(F.in[0] + (size_t)(r2 < T ? r2 : r1) * DM, lane, va); asm volatile("" ::: "memory");
                rms_row_finish(vb, WSP(bf16_t, WS_HB) + (size_t)r1 * DM, lane, WSP(float, WS_RSTDX) + r1); asm volatile("" ::: "memory");
                if (r2 >= T) break;
                r = r2;
            }
        }
    }
    for (int r = gw; r < NBATCH * MEMLEN; r += ngw) rms_row_bf16(F.in[1] + (size_t)r * DM, F.in[16], WSP(bf16_t, WS_MEMN) + (size_t)r * DM, lane);
}

__device__ __forceinline__ void gmlp_phase(Frame& F) {
    const bf16_t* UV = WSP(bf16_t, WS_UV); bf16_t* AB = WSP(bf16_t, WS_AB); const bf16_t* WSPB = WSP(bf16_t, WS_WSPB);
    const stat_t* vsum = STAT(F, ST_VSUM); const stat_t* vsq = STAT(F, ST_VSQ); stat_t* ssq_a = STAT(F, ST_A);
    const float *g_v = F.in[4], *b_v = F.in[5], *bsp = F.in[7];
    int tid_ = F.tid; asm volatile("" : "+v"(tid_));
    const int tid = tid_, wid = tid >> 6, lane = tid & 63, r32 = lane & 31, hi = lane >> 5, gsel = wid >> 2, w4 = wid & 3;
    char* lds = (char*)F.lds;
    float* stage = (float*)(lds + 65536 + wid * 8192);
    const int vb0 = (int)(uintptr_t)lds + att::v_rd_base(lane);
    const int sr = tid >> 4, c8 = (tid & 15) * 8;
    const bool deal3 = (F.G == 256);
    const int bxg = (int)blockIdx.x, nmine = deal3 ? (bxg < 128 ? 1 : 3) : (512 - F.vcu + F.G - 1) / F.G;
    for (int ui = 0; ui < nmine; ++ui) {
        const int unit = deal3 ? (bxg < 128 ? bxg : 128 + 3 * (bxg - 128) + ui) : F.vcu + ui * F.G;
        const int t0 = (unit >> 2) * 128, gp = unit & 3;
        const int g = gp * 2 + gsel, rr = lane >> 1, cb = (lane & 1) * 32, t = 32 * w4 + rr, gr = t0 + t;
        u32x4 wv[2][4]; stat_t rs_[4], rq_[4];
#pragma unroll
        for (int k = 0; k < 4; ++k) { rs_[k] = vsum[t0 + sr + 32 * k]; rq_[k] = vsq[t0 + sr + 32 * k]; }
#pragma unroll
        for (int gl = 0; gl < 2; ++gl)
#pragma unroll
            for (int k = 0; k < 4; ++k) wv[gl][k] = *(const u32x4*)(UV + (size_t)(t0 + sr + 32 * k) * DM + GW + (gp * 2 + gl) * 128 + c8);
        asm volatile("" ::: "memory");
        u32x4 uu[2][4]; bf16x8 pa[2][4];
#pragma unroll
        for (int half = 0; half < 2; ++half)
#pragma unroll
            for (int i = 0; i < 4; ++i) uu[half][i] = *(const u32x4*)(UV + (size_t)gr * DM + g * 128 + half * 64 + cb + 8 * i);
#pragma unroll
        for (int st = 0; st < 2; ++st) { const bf16_t* wrow = WSPB + ((size_t)(g * 128 + 32 * w4 + r32) * 128 + 64 * st + 8 * hi);
#pragma unroll
            for (int j = 0; j < 4; ++j) pa[st][j] = *(const bf16x8*)(wrow + 16 * j); }
        const float bias = bsp[g * 128 + t];
        asm volatile("" ::: "memory");
        {
            float mean[4], rstd[4];
#pragma unroll
            for (int k = 0; k < 4; ++k) { mean[k] = (float)((double)(long long)rs_[k] * 2.3283064365386963e-10) * (1.0f / GW); const float var = (float)((double)(long long)rq_[k] * 2.3283064365386963e-10) * (1.0f / GW) - mean[k] * mean[k]; rstd[k] = 1.0f / sqrtf(var + 1e-5f); }
#pragma unroll
            for (int gl = 0; gl < 2; ++gl) { const int gg = gp * 2 + gl;
                const f32x4 ga = *(const f32x4*)(g_v + gg * 128 + c8), gb = *(const f32x4*)(g_v + gg * 128 + c8 + 4), ba = *(const f32x4*)(b_v + gg * 128 + c8), bb = *(const f32x4*)(b_v + gg * 128 + c8 + 4);
#pragma unroll
                for (int k = 0; k < 4; ++k) { const int sl = sr + 32 * (k & 1), st = k >> 1;
                    const u32x4 w = wv[gl][k];
                    f32x4 x0 = {bf_lo(w.x), bf_hi(w.x), bf_lo(w.y), bf_hi(w.y)}, x1 = {bf_lo(w.z), bf_hi(w.z), bf_lo(w.w), bf_hi(w.w)};
                    x0 = (x0 - mean[k]) * rstd[k] * ga + ba; x1 = (x1 - mean[k]) * rstd[k] * gb + bb;
                    *(u32x4*)(lds + (gl * 2 + st) * 16384 + att::v_st(sl, c8)) = pack8(x0, x1); } }
        }
        __syncthreads();
        f32x16 o[4] = {};
#pragma unroll
        for (int st = 0; st < 2; ++st) {
            if (st == 1 && w4 < 2) continue;
            att::pv_d0(o, vb0 + (gsel * 2 + st) * 16384, pa[st][0], pa[st][1], pa[st][2], pa[st][3]);
        }
#pragma unroll
        for (int half = 0; half < 2; ++half) {
#pragma unroll
            for (int d = 0; d < 2; ++d)
#pragma unroll
                for (int r = 0; r < 16; ++r) stage[((r & 3) + 8 * (r >> 2) + 4 * hi) * 64 + d * 32 + r32] = o[2 * half + d][r];
            asm volatile("s_waitcnt lgkmcnt(0)" ::: "memory");
            float s2 = 0.f;
            const size_t goff = (size_t)gr * DM + g * 128 + half * 64 + cb;
#pragma unroll
            for (int i = 0; i < 4; ++i) {
                const f32x4 sa = *(const f32x4*)(stage + rr * 64 + cb + 8 * i), sb = *(const f32x4*)(stage + rr * 64 + cb + 8 * i + 4);
                const u32x4 w = uu[half][i];
                const f32x4 u0 = {bf_lo(w.x), bf_hi(w.x), bf_lo(w.y), bf_hi(w.y)}, u1 = {bf_lo(w.z), bf_hi(w.z), bf_lo(w.w), bf_hi(w.w)};
                const f32x4 a0 = u0 * (sa + bias), a1 = u1 * (sb + bias);
                *(u32x4*)(AB + goff + 8 * i) = pack8(a0, a1);
                s2 += (a0.x * a0.x + a0.y * a0.y) + (a0.z * a0.z + a0.w * a0.w) + (a1.x * a1.x + a1.y * a1.y) + (a1.z * a1.z + a1.w * a1.w);
            }
            s2 += __shfl_xor(s2, 1);
            if ((lane & 1) == 0) stat_add(ssq_a + gr, s2);
            asm volatile("s_waitcnt lgkmcnt(0)" ::: "memory");
        }
        __syncthreads();
    }
}

__device__ __forceinline__ void moe_tiles(Frame& F) {
    LAS int* ts = (LAS int*)(F.lds + TS_OFF); const int* cnt = (const int*)(F.ctl + CW_CNT);
    if (F.tid < 64) {
        const int lane = F.tid, c = cnt[lane], nt = (c + 255) >> 8, hf = (nt > 0 && (c - (nt - 1) * 256) <= 128) ? 1 : 0;
        int a = nt, f = nt - hf, h = hf;
#pragma unroll
        for (int o = 1; o < 64; o <<= 1) { const int ua = __shfl_up(a, o), uf = __shfl_up(f, o), uh = __shfl_up(h, o); if (lane >= o) { a += ua; f += uf; h += uh; } }
        ts[lane] = a - nt; ts[80 + lane] = f - (nt - hf); ts[160 + lane] = h - hf;
        if (lane == 63) { ts[NEXP] = a; ts[80 + NEXP] = f; ts[160 + NEXP] = h; }
    }
    __syncthreads();
}

__device__ __forceinline__ void ld_row(const bf16_t* p, int lane, u32x4 (&v)[4]) {
#pragma unroll
    for (int j = 0; j < 4; ++j) v[j] = *(const u32x4*)(p + 8 * (lane + 64 * j));
}
__device__ __forceinline__ void ld_row8(const unsigned char* p, int lane, u32x2 (&v)[4]) {
#pragma unroll
    for (int j = 0; j < 4; ++j) v[j] = *(const u32x2*)(p + 8 * (lane + 64 * j));
}
__device__ __forceinline__ float mix_row8(const u32x4 (&x)[4], const u32x2 (&a)[4], const u32x2 (&b)[4], float w0, float w1, f32x4 (&v)[8]) {
    float s = 0.f;
#pragma unroll
    for (int j = 0; j < 4; ++j) {
        const f32x2 a0 = __builtin_amdgcn_cvt_pk_f32_fp8((int)a[j].x, false), a1 = __builtin_amdgcn_cvt_pk_f32_fp8((int)a[j].x, true), a2 = __builtin_amdgcn_cvt_pk_f32_fp8((int)a[j].y, false), a3 = __builtin_amdgcn_cvt_pk_f32_fp8((int)a[j].y, true);
        const f32x2 b0 = __builtin_amdgcn_cvt_pk_f32_fp8((int)b[j].x, false), b1 = __builtin_amdgcn_cvt_pk_f32_fp8((int)b[j].x, true), b2 = __builtin_amdgcn_cvt_pk_f32_fp8((int)b[j].y, false), b3 = __builtin_amdgcn_cvt_pk_f32_fp8((int)b[j].y, true);
        f32x4 lo, hi;
        lo.x = bf_lo(x[j].x) + (w0 * a0.x + w1 * b0.x); lo.y = bf_hi(x[j].x) + (w0 * a0.y + w1 * b0.y);
        lo.z = bf_lo(x[j].y) + (w0 * a1.x + w1 * b1.x); lo.w = bf_hi(x[j].y) + (w0 * a1.y + w1 * b1.y);
        hi.x = bf_lo(x[j].z) + (w0 * a2.x + w1 * b2.x); hi.y = bf_hi(x[j].z) + (w0 * a2.y + w1 * b2.y);
        hi.z = bf_lo(x[j].w) + (w0 * a3.x + w1 * b3.x); hi.w = bf_hi(x[j].w) + (w0 * a3.y + w1 * b3.y);
        v[2 * j] = lo; v[2 * j + 1] = hi;
        s += ((lo.x * lo.x + lo.y * lo.y) + (lo.z * lo.z + lo.w * lo.w)) + ((hi.x * hi.x + hi.y * hi.y) + (hi.z * hi.z + hi.w * hi.w));
    }
    return s;
}
__device__ __forceinline__ float mix_row(const u32x4 (&x)[4], const u32x4 (&a)[4], const u32x4 (&b)[4], float w0, float w1, f32x4 (&v)[8]) {
    float s = 0.f;
#pragma unroll
    for (int j = 0; j < 4; ++j) {
        f32x4 lo, hi;
        lo.x = bf_lo(x[j].x) + (w0 * bf_lo(a[j].x) + w1 * bf_lo(b[j].x)); lo.y = bf_hi(x[j].x) + (w0 * bf_hi(a[j].x) + w1 * bf_hi(b[j].x));
        lo.z = bf_lo(x[j].y) + (w0 * bf_lo(a[j].y) + w1 * bf_lo(b[j].y)); lo.w = bf_hi(x[j].y) + (w0 * bf_hi(a[j].y) + w1 * bf_hi(b[j].y));
        hi.x = bf_lo(x[j].z) + (w0 * bf_lo(a[j].z) + w1 * bf_lo(b[j].z)); hi.y = bf_hi(x[j].z) + (w0 * bf_hi(a[j].z) + w1 * bf_hi(b[j].z));
        hi.z = bf_lo(x[j].w) + (w0 * bf_lo(a[j].w) + w1 * bf_lo(b[j].w)); hi.w = bf_hi(x[j].w) + (w0 * bf_hi(a[j].w) + w1 * bf_hi(b[j].w));
        v[2 * j] = lo; v[2 * j + 1] = hi;
        s += ((lo.x * lo.x + lo.y * lo.y) + (lo.z * lo.z + lo.w * lo.w)) + ((hi.x * hi.x + hi.y * hi.y) + (hi.z * hi.z + hi.w * hi.w));
    }
    return s;
}
__device__ __forceinline__ void st_row(float* o, const float* gf, int lane, const f32x4 (&v)[8], float rs) {
#pragma unroll
    for (int j = 0; j < 4; ++j) { const int c = 8 * (lane + 64 * j); const f32x4 g0 = *(const f32x4*)(gf + c), g1 = *(const f32x4*)(gf + c + 4);
        *(f32x4*)(o + c) = v[2 * j] * rs * g0; *(f32x4*)(o + c + 4) = v[2 * j + 1] * rs * g1; }
}
__device__ __forceinline__ void final_phase(Frame& F) {
    const unsigned char* YS = WSP(unsigned char, WS_YS); const bf16_t* XB = WSP(bf16_t, WS_HB); const float* gf = F.in[29];
    const int* toke = WSP(int, WS_TOKE); const float* tokw = WSP(float, WS_TOKW); const LAS int* ts = (const LAS int*)(F.lds + TS_OFF);
    const int gw = F.vcu * 8 + F.wave, ngw = F.G * 8, lane = F.lane;
    for (int r = gw; r < T; r += 2 * ngw) {
        const int r2 = (r + ngw < T) ? r + ngw : r;
        const int ea = toke[2 * r], eb = toke[2 * r + 1], ec = toke[2 * r2], ed = toke[2 * r2 + 1];
        const size_t sa = (size_t)(ts[ea >> 16] * 256 + (ea & 0xffff)), sb = (size_t)(ts[eb >> 16] * 256 + (eb & 0xffff));
        const size_t sc = (size_t)(ts[ec >> 16] * 256 + (ec & 0xffff)), sd = (size_t)(ts[ed >> 16] * 256 + (ed & 0xffff));
        u32x4 x0[4], x1[4]; u32x2 a0[4], b0[4], a1[4], b1[4];
        ld_row(XB + (size_t)r * DM, lane, x0); ld_row8(YS + sa * DM, lane, a0); ld_row8(YS + sb * DM, lane, b0);
        ld_row(XB + (size_t)r2 * DM, lane, x1); ld_row8(YS + sc * DM, lane, a1); ld_row8(YS + sd * DM, lane, b1);
        f32x4 v0[8], v1[8];
        const float s0 = mix_row8(x0, a0, b0, tokw[2 * r], tokw[2 * r + 1], v0);
        const float s1 = mix_row8(x1, a1, b1, tokw[2 * r2], tokw[2 * r2 + 1], v1);
        const float rs0 = 1.0f / sqrtf(wave_sum(s0) * (1.0f / DM) + EPS), rs1 = 1.0f / sqrtf(wave_sum(s1) * (1.0f / DM) + EPS);
        st_row(F.out + (size_t)r * DM, gf, lane, v0, rs0);
        st_row(F.out + (size_t)r2 * DM, gf, lane, v1, rs1);
    }
}

constexpr int NPH = 13;
struct Args { const float* in[30]; float* out; unsigned char* ws; int ph_lo, ph_hi; };
__global__ void __launch_bounds__(512, 2) fwd(Args args) {
    extern __shared__ __attribute__((aligned(16))) unsigned char lds_raw[];
    Frame F;
    F.lds = (LAS unsigned char*)lds_raw;
    F.tid = threadIdx.x; F.lane = F.tid & 63; F.wave = __builtin_amdgcn_readfirstlane(F.tid >> 6);
    F.G = gridDim.x; { const int bx = blockIdx.x; F.vcu = (F.G % 8 == 0) ? (bx % 8) * (F.G / 8) + bx / 8 : bx; }
#pragma unroll
    for (int i = 0; i < 30; ++i) F.in[i] = args.in[i];
    F.out = args.out; F.ws = args.ws; F.ctl = (unsigned*)(args.ws + WS_CTL);
    volatile LAS unsigned* MISC = (volatile LAS unsigned*)(F.lds + MISC_OFF);
    if (F.tid < 32) MISC[F.tid] = 0u;
    __syncthreads();
    const int lo = args.ph_lo, hi = args.ph_hi;
    const bool multi = (hi - lo) > 1;
    XcdBarrier bar; bar.bar = F.ctl + CW_BAR; bar.x = 0; bar.st = nullptr;
    if (multi) bar = xcd_barrier_post(F.ctl + CW_BAR, MISC + 8);
#ifndef ONLYP
#define ONLYP -1
#endif
#define IN(k) ((ONLYP < 0 || ONLYP == (k)) && lo <= (k) && (k) < hi)
#define SEAM(k) do { if (IN(k) && IN((k) + 1)) xcd_barrier(bar); } while (0)
    float* const out = F.out;
    const int bx = (int)blockIdx.x;

    if (IN(0)) { p0_prologue(F); }
    SEAM(0);
    if (IN(1)) {
        pg8::Gemm g{WSP(bf16_t, WS_HB), WSP(bf16_t, WS_WIN), DM, DM, DM}; pg8::StaticOrder S0; S0.init(T, INWP, F.G, bx);
        EpiZ E{WSP(bf16_t, WS_UV), WSP(bf16_t, WS_CQ), WSP(bf16_t, WS_CKV), WSP(bf16_t, WS_KR), STAT(F, ST_VSUM), STAT(F, ST_VSQ), STAT(F, ST_Q), STAT(F, ST_KV), WSP(float, WS_COS), WSP(float, WS_SIN)};
        const int kcut = (bx & 7) >> 1;
        { pg8::SubOrder S{S0, 0, kcut}; pg8::gemm_phase(F.lds, g, S, E); }
        __syncthreads(); expert_convert(F, 0, F.G == 256 ? 18 : (1 << 20)); __syncthreads();
        { pg8::SubOrder S{S0, kcut, 1 << 20}; pg8::gemm_phase(F.lds, g, S, E); }
    }
    SEAM(1);
    if (IN(2)) {
        { pg8::Gemm g{WSP(bf16_t, WS_CQ), WSP(bf16_t, WS_WUQ), QL, QL, QL}; pg8::StaticOrder S; S.init(T, NQ, F.G, bx);
          EpiQ E{WSP(bf16_t, WS_Q), STAT(F, ST_Q), WSP(float, WS_COS), WSP(float, WS_SIN)};
          pg8::gemm_phase(F.lds, g, S, E); }
        { pg8::Gemm g{WSP(bf16_t, WS_CKV), WSP(bf16_t, WS_WUKV), KVL, KVL, KVL}; pg8::StaticOrder S; S.init(T, NKV, F.G, (bx + 128) % F.G);
          EpiScaleBf16 E{WSP(bf16_t, WS_KV), NKV, STAT(F, ST_KV), 1.0f / KVL};
          pg8::gemm_phase(F.lds, g, S, E); }
        __syncthreads();
        gmlp_phase(F);
    }
    SEAM(2);
    if (IN(3)) {
        const bf16_t* Q = WSP(bf16_t, WS_Q); const bf16_t* KV = WSP(bf16_t, WS_KV); const bf16_t* KR = WSP(bf16_t, WS_KR); bf16_t* MB = WSP(bf16_t, WS_AB);
        const int cgrp = bx & 1;
        if (F.G == 256 && cgrp == 0) { expert_convert(F, 18, 36); __syncthreads(); }
        for (int v = F.vcu; v < 256; v += F.G) {
            const int bh = v >> 2, b = bh >> 3, h = bh & 7, s = v & 3;
#pragma unroll 1
            for (int half = 0; half < 2; ++half) {
                const int qb = half ? 7 - s : s; const size_t r0 = (size_t)b * SEQ + qb * 256, k0 = (size_t)b * SEQ;
                att::attn_unit<64, true, NQ, NKV, DM>(Q + r0 * NQ + h * 192, KV + k0 * NKV + h * 256, KV + k0 * NKV + h * 256 + 128, KR + k0 * ROPE,
                                                      MB + r0 * DM + GW + h * 128, 4 * (qb + 1), STAT(F, ST_M) + r0, (char*)lds_raw);
            }
        }
        if (F.G == 256 && cgrp == 1) { __syncthreads(); expert_convert(F, 18, 36); }
    }
    SEAM(3);
    if (IN(4)) {
        pg8::Gemm g{WSP(bf16_t, WS_AB), WSP(bf16_t, WS_WOA), DM, DM, DM}; pg8::StaticOrder S0; S0.init(T, DM, F.G, bx);
        EpiMix E{WSP(float, WS_RSTDX), STAT(F, ST_A), STAT(F, ST_M), WSP(bf16_t, WS_HB), STAT(F, ST_X1)};
        const int kcut4 = (bx & 7) % 3;
        { pg8::SubOrder S{S0, 0, kcut4}; pg8::gemm_phase(F.lds, g, S, E); }
        if (F.G == 256) { __syncthreads(); expert_convert(F, 36, 1 << 20); __syncthreads(); }
        { pg8::SubOrder S{S0, kcut4, 1 << 20}; pg8::gemm_phase(F.lds, g, S, E); }
    }
    SEAM(4);
    if (IN(5)) {
        { pg8::Gemm g{WSP(bf16_t, WS_HB), WSP(bf16_t, WS_WMQ), DM, DM, DM}; pg8::StaticOrder S; S.init(T, 512, F.G, bx);
          EpiScaleBf16 E{WSP(bf16_t, WS_XQ), 512, STAT(F, ST_X1), 1.0f / DM};
          pg8::gemm_phase(F.lds, g, S, E); }
        { pg8::Gemm g{WSP(bf16_t, WS_MEMN), WSP(bf16_t, WS_WMKV), DM, DM, DM}; pg8::StaticOrder S; S.init(NBATCH * MEMLEN, 1024, F.G, (bx + 128) % F.G);
          EpiScaleBf16 E{WSP(bf16_t, WS_MKV), 1024, nullptr, 0.f};
          pg8::gemm_phase(F.lds, g, S, E); }
        { pg8::Gemm g{WSP(bf16_t, WS_HB), WSP(bf16_t, WS_WR), DM, DM, DM}; pg8::StaticOrder S; S.init(T, 256, F.G, (bx + 96) % F.G);
          EpiLog1 E{WSP(float, WS_LOG1)};
          pg8::gemm_phase(F.lds, g, S, E); }
        { pg8::Gemm g{WSP(bf16_t, WS_WR), WSP(bf16_t, WS_WMOB), DM, DM, DM}; pg8::StaticOrder S; S.init(256, 512, F.G, (bx + 32) % F.G);
          EpiScaleF8 E{WSP(unsigned char, WS_W2T), 512, 128.f};
          pg8::gemm_phase(F.lds, g, S, E); }
    }
    SEAM(5);
    if (IN(6)) {
        const bf16_t* XQ = WSP(bf16_t, WS_XQ); const bf16_t* MKV = WSP(bf16_t, WS_MKV); unsigned char* XO = WSP(unsigned char, WS_XO);
        for (int v = F.vcu; v < 256; v += F.G) {
            const int bh = v >> 3, b = bh >> 2, h = bh & 3, qb = v & 7; const size_t r0 = (size_t)b * SEQ + qb * 256, k0 = (size_t)b * MEMLEN;
            att::attn_unit<0, false, 512, 1024, 512, true>(XQ + r0 * 512 + h * 128, MKV + k0 * 1024 + h * 128, MKV + k0 * 1024 + 512 + h * 128, nullptr,
                                                     (bf16_t*)(XO + r0 * 512 + h * 128), 4, nullptr, (char*)lds_raw);
        }
    }
    SEAM(6);
    if (IN(7)) {
        pg8::Gemm g{WSP(bf16_t, WS_XO), WSP(bf16_t, WS_WMO), 256, 256, 256}; pg8::StaticOrder S; S.init(T, DM, F.G, bx);
        EpiResidB E{WSP(bf16_t, WS_HB), STAT(F, ST_X2)};
        pg8::gemm_phase(F.lds, g, S, E);
    }
    SEAM(7);
    if (IN(8)) {
        if (bx < 64 || F.G != 256) {
            pg8::Gemm g{WSP(bf16_t, WS_XO), WSP(bf16_t, WS_W2T), 256, 256, 256}; pg8::StaticOrder S; S.init(T, 256, F.G, bx);
            EpiRoute E{WSP(float, WS_LOG1), STAT(F, ST_X2), WSP(float, WS_RB), WSP(float, WS_TOKW), WSP(int, WS_ROWTOK), WSP(int, WS_TOKE), (int*)(F.ctl + CW_CNT)};
            pg8::gemm_phase(F.lds, g, S, E);
        }
        {
            const int nw = (F.G == 256) ? 192 * 8 : F.G * 8, w0 = (F.G == 256) ? (bx - 64) * 8 + F.wave : bx * 8 + F.wave;
            if (F.G != 256 || bx >= 64) {
                const bf16_t* XBp = WSP(bf16_t, WS_HB); unsigned char* X8p = WSP(unsigned char, WS_X8);
                const int lane = F.lane;
                f32x4 gg[4][2];
#pragma unroll
                for (int j = 0; j < 4; ++j) { gg[j][0] = *(const f32x4*)(F.in[21] + 8 * (lane + 64 * j)); gg[j][1] = *(const f32x4*)(F.in[21] + 8 * (lane + 64 * j) + 4); }
                auto ld = [&](int r, u32x4 (&v)[4]) {
#pragma unroll
                    for (int j = 0; j < 4; ++j) v[j] = *(const u32x4*)(XBp + (size_t)r * DM + 8 * (lane + 64 * j)); };
                auto st = [&](int r, const u32x4 (&v)[4]) {
#pragma unroll
                    for (int j = 0; j < 4; ++j) { const u32x4 w = v[j];
                        const f32x4 a = {bf_lo(w.x), bf_hi(w.x), bf_lo(w.y), bf_hi(w.y)}, b = {bf_lo(w.z), bf_hi(w.z), bf_lo(w.w), bf_hi(w.w)};
                        *(u32x2*)(X8p + (size_t)r * DM + 8 * (lane + 64 * j)) = pack8_fp8(a * gg[j][0], b * gg[j][1]); } };
                u32x4 va[4], vb[4];
                int r = w0;
                if (r < T) {
                    ld(r, va); asm volatile("" ::: "memory");
                    for (;;) {
                        const int r1 = r + nw, r2 = r1 + nw;
                        ld(r1 < T ? r1 : r, vb); asm volatile("" ::: "memory");
                        st(r, va); asm volatile("" ::: "memory");
                        if (r1 >= T) break;
                        ld(r2 < T ? r2 : r1, va); asm volatile("" ::: "memory");
                        st(r1, vb); asm volatile("" ::: "memory");
                        if (r2 >= T) break;
                        r = r2;
                    }
                }
            }
        }
    }
    SEAM(8);
    if (IN(9) && !IN(8)) { }
    if (IN(9) && !IN(10)) { }
    if (IN(10)) {
        moe_tiles(F);
        MoeOrder S{(const LAS int*)(F.lds + TS_OFF), (const int*)(F.ctl + CW_CNT), WSP(int, WS_ROWTOK), 4, F.G, F.vcu, true, true};
        pg8::Gemm g{WSP(bf16_t, WS_X8), WSP(bf16_t, WS_WGU), DM / 2, DM / 2, DM / 2};
        EpiGU E{WSP(unsigned char, WS_H), STAT(F, ST_X2), (const int*)(F.ctl + CW_CNT), WSP(int, WS_ROWTOK)};
        pg8::gemm_phase(F.lds, g, S, E);
    }
    SEAM(10);
    if (IN(11)) {
        moe_tiles(F);
        MoeOrder S{(const LAS int*)(F.lds + TS_OFF), (const int*)(F.ctl + CW_CNT), WSP(int, WS_ROWTOK), 8, F.G, F.vcu, false, false};
        pg8::Gemm g{WSP(bf16_t, WS_H), WSP(bf16_t, WS_WD), DE / 2, DE / 2, DE / 2};
        EpiDown E{WSP(unsigned char, WS_YS)};
        pg8::gemm_phase(F.lds, g, S, E);
    }
    SEAM(11);
    if (IN(12)) { moe_tiles(F); final_phase(F); }
#undef IN
#undef SEAM
}

#ifndef MK_PER_PHASE
#define MK_PER_PHASE 0
#endif
extern "C" void kernel_launch(void* const* d_in, const int* in_sizes, int n_in, void* d_out, int out_size, void* d_ws, size_t ws_size, hipStream_t stream) {
    static int grid = 0;
    if (grid == 0) {
        if (n_in != 30 || out_size != T * DM || ws_size < WS_END) { fprintf(stderr, "kernel_launch: unexpected shapes / workspace (%d inputs, out %d, ws %zu, need %zu)\n", n_in, out_size, ws_size, (size_t)WS_END); grid = -1; return; }
        int dev = 0, cus = 0, per_cu = 0;
        if (hipGetDevice(&dev) != hipSuccess || hipDeviceGetAttribute(&cus, hipDeviceAttributeMultiprocessorCount, dev) != hipSuccess) { grid = -1; return; }
        if (hipFuncSetAttribute((const void*)fwd, hipFuncAttributeMaxDynamicSharedMemorySize, LDS_BYTES) != hipSuccess) { fprintf(stderr, "kernel_launch: hipFuncSetAttribute failed\n"); grid = -1; return; }
        if (hipOccupancyMaxActiveBlocksPerMultiprocessor(&per_cu, (const void*)fwd, 512, LDS_BYTES) != hipSuccess || per_cu < 1) fprintf(stderr, "kernel_launch: occupancy query says %d\n", per_cu);
        (void)hipGetLastError();
        grid = cus;
    }
    if (grid < 0) return;
    if (hipMemsetAsync((char*)d_ws + WS_CTL, 0, CTL_ZERO_BYTES, stream) != hipSuccess) return;
    Args a{};
    for (int i = 0; i < 30; ++i) a.in[i] = (const float*)d_in[i];
    a.out = (float*)d_out; a.ws = (unsigned char*)d_ws;
#if MK_PER_PHASE
    for (int p = 0; p < NPH; ++p) { a.ph_lo = p; a.ph_hi = p + 1; hipLaunchKernelGGL(fwd, dim3(grid), dim3(512), LDS_BYTES, stream, a); }
#else
    a.ph_lo = 0; a.ph_hi = NPH; hipLaunchKernelGGL(fwd, dim3(grid), dim3(512), LDS_BYTES, stream, a);
#endif
}
```
